# Optimizing an MI355X kernel written in HIP

```python
import math
import jax
import jax.numpy as jnp
from jax import lax
import numpy as np

D_MODEL = 1024
BATCH = 4
SEQ = 8192
DEPTH = 1

HEAD_DIM = 64
Q_BLOCK = 128
DIL_GROUPS = ((128, 1), (512, 4), (2048, 16))
A_HEADS_PER_GROUP = 4
A_HEADS = A_HEADS_PER_GROUP * len(DIL_GROUPS)
A_WIDTH = A_HEADS * HEAD_DIM
A_OUT = A_HEADS_PER_GROUP * HEAD_DIM
B_HEADS = 8
B_KV_HEADS = 2
B_GQA = B_HEADS // B_KV_HEADS
B_WIDTH = B_HEADS * HEAD_DIM
B_KV_WIDTH = B_KV_HEADS * HEAD_DIM
CMP_LEN = 32
CMP_STRIDE = 16
CMP_HIDDEN = 256
SLC_LEN = 64
SLC_TOPK = 16
WIN = 512
N_GROUPS = 4
EXP_PER_GROUP = 8
N_EXPERTS = N_GROUPS * EXP_PER_GROUP
D_EXPERT = 512
MOE_TOP_K = 2
MOE_BLOCK = 128
IN_SIZES = (3 * A_WIDTH, B_WIDTH, 6 * B_KV_WIDTH, 3 * B_HEADS, 2 * D_MODEL)
IN_COLS = sum(IN_SIZES)
ALPHA = (2.0 * DEPTH) ** 0.25
BETA = (8.0 * DEPTH) ** -0.25
LN_EPS = 1e-5
FORCE_BONUS = 1e4
TINY = 1e-30
ATTN_SCALE = HEAD_DIM ** -0.5

kernel_name = 'hybrid_dilated_nsa_hmoe_deepnorm'


def layer_norm(x, gain, bias):
    xf = x.astype(jnp.float32)
    mu = jnp.mean(xf, axis=-1, keepdims=True)
    var = jnp.mean(jnp.square(xf - mu), axis=-1, keepdims=True)
    y = (xf - mu) * lax.rsqrt(var + LN_EPS) * gain + bias
    return y.astype(x.dtype)


def alibi_slopes(n):
    return jnp.exp2(-8.0 * jnp.arange(1, n + 1, dtype=jnp.float32) / n)


def masked_softmax(s, mask):
    s = jnp.where(mask, s.astype(jnp.float32), -jnp.inf)
    m = jnp.max(s, axis=-1, keepdims=True)
    m = jnp.where(jnp.isfinite(m), m, 0.0)
    p = jnp.exp(s - m)
    l = jnp.sum(p, axis=-1, keepdims=True)
    return p / jnp.maximum(l, TINY), m + jnp.log(l)


def dilated_group(q, k, v, window, dil, slopes):
    B_, S_, H, E = q.shape
    L = S_ // dil
    nb = -(-L // Q_BLOCK)
    Lp = nb * Q_BLOCK
    n_back = window // dil

    def to_sub(t):
        t = t.reshape(B_, L, dil, H, E).transpose(0, 2, 3, 1, 4)
        t = jnp.pad(t, ((0, 0), (0, 0), (0, 0), (0, Lp - L), (0, 0)))
        return t.reshape(B_, dil, H, nb, Q_BLOCK, E)

    def with_prev(t):
        prev = jnp.pad(t, ((0, 0), (0, 0), (0, 0), (1, 0), (0, 0), (0, 0)))[:, :, :, :-1]
        return jnp.concatenate([prev, t], axis=4)

    qs = to_sub(q)
    kk = with_prev(to_sub(k))
    vv = with_prev(to_sub(v))
    qi = Q_BLOCK + jnp.arange(Q_BLOCK)
    kj = jnp.arange(2 * Q_BLOCK)
    delta = qi[:, None] - kj[None, :]
    key_idx = jnp.arange(nb)[:, None] * Q_BLOCK - Q_BLOCK + kj[None, :]
    mask = ((delta >= 0) & (delta <= n_back))[None] & (key_idx >= 0)[:, None, :]
    s = jnp.einsum('bdhnqe,bdhnke->bdhnqk', qs, kk).astype(jnp.float32) * ATTN_SCALE
    s = s - slopes[:, None, None, None] * (delta * dil).astype(jnp.float32)
    probs, lse = masked_softmax(s, mask)
    o = jnp.einsum('bdhnqk,bdhnke->bdhnqe', probs, vv)
    o = o.reshape(B_, dil, H, Lp, E)[:, :, :, :L].transpose(0, 3, 1, 2, 4).reshape(B_, S_, H, E)
    lse = lse[..., 0].reshape(B_, dil, H, Lp)[:, :, :, :L].transpose(0, 3, 1, 2).reshape(B_, S_, H)
    return o, lse


def dilated_mixer(a_qkv):
    B_, S_, _ = a_qkv.shape
    n_g = len(DIL_GROUPS)
    qkv = a_qkv.reshape(B_, S_, 3, n_g, A_HEADS_PER_GROUP, HEAD_DIM)
    slopes = alibi_slopes(A_HEADS).reshape(n_g, A_HEADS_PER_GROUP)
    outs, lses = [], []
    for g, (window, dil) in enumerate(DIL_GROUPS):
        o, lse = dilated_group(qkv[:, :, 0, g], qkv[:, :, 1, g], qkv[:, :, 2, g], window, dil, slopes[g])
        outs.append(o)
        lses.append(lse)
    w = jax.nn.softmax(jnp.stack(lses), axis=0)
    o = jnp.sum(w[..., None] * jnp.stack(outs), axis=0)
    return o.reshape(B_, S_, A_OUT)


def compress_tokens(kv, pos_emb, w1, w2):
    B_, S_, G, E = kv.shape
    n_chunk = S_ // CMP_STRIDE
    ratio = CMP_LEN // CMP_STRIDE
    n_cmp = n_chunk - ratio + 1
    chunks = kv.reshape(B_, n_chunk, CMP_STRIDE, G, E)
    blocks = jnp.concatenate([chunks[:, r:r + n_cmp] for r in range(ratio)], axis=2)
    blocks = blocks + pos_emb[:, None, :]
    flat = blocks.transpose(0, 1, 3, 2, 4).reshape(B_, n_cmp, G, CMP_LEN * E)
    return jax.nn.gelu(flat @ w1) @ w2


def nsa_mixer(b_q, b_kv, b_gate, cmp_pos_k, cmp_w1_k, cmp_w2_k, cmp_pos_v, cmp_w1_v, cmp_w2_v):
    B_, S_, _ = b_q.shape
    G, R, E = B_KV_HEADS, B_GQA, HEAD_DIM
    q = b_q.reshape(B_, S_, G, R, E)
    kv = b_kv.reshape(B_, S_, 6, G, E)
    k_cmp = compress_tokens(kv[:, :, 0], cmp_pos_k, cmp_w1_k, cmp_w2_k)
    v_cmp = compress_tokens(kv[:, :, 1], cmp_pos_v, cmp_w1_v, cmp_w2_v)
    n_cmp = k_cmp.shape[1]
    n_slc = S_ // SLC_LEN
    n_sel = min(SLC_TOPK, n_slc)
    k_blk = kv[:, :, 2].reshape(B_, n_slc, SLC_LEN, G, E).transpose(0, 3, 1, 2, 4)
    v_blk = kv[:, :, 3].reshape(B_, n_slc, SLC_LEN, G, E).transpose(0, 3, 1, 2, 4)
    pad = ((0, 0), (WIN, 0), (0, 0), (0, 0))
    k_win = jnp.pad(kv[:, :, 4], pad)
    v_win = jnp.pad(kv[:, :, 5], pad)
    gates = jax.nn.sigmoid(b_gate).reshape(B_, S_, G, R, 3)
    slopes = alibi_slopes(B_HEADS).reshape(G, R)
    c_start = jnp.arange(n_cmp) * CMP_STRIDE
    cmp_end = c_start + (CMP_LEN - 1)
    s_start = jnp.arange(n_slc) * SLC_LEN
    overlap = ((c_start[:, None] < s_start[None, :] + SLC_LEN) &
               (c_start[:, None] + CMP_LEN > s_start[None, :])).astype(jnp.float32)
    blk_ids = jnp.arange(n_slc)
    bi = jnp.arange(B_)[:, None, None, None]
    gi = jnp.arange(G)[None, :, None, None]

    def one_block(n):
        t0 = n * Q_BLOCK
        t = t0 + jnp.arange(Q_BLOCK)
        qb = lax.dynamic_slice_in_dim(q, t0, Q_BLOCK, axis=1).transpose(0, 2, 3, 1, 4)
        gb = lax.dynamic_slice_in_dim(gates, t0, Q_BLOCK, axis=1).transpose(0, 2, 3, 1, 4)
        s_c = jnp.einsum('bgrqe,bcge->bgrqc', qb, k_cmp).astype(jnp.float32) * ATTN_SCALE
        p_c, _ = masked_softmax(s_c, cmp_end[None, :] <= t[:, None])
        o_c = jnp.einsum('bgrqc,bcge->bgrqe', p_c, v_cmp)
        imp = jnp.einsum('bgrqc,cj->bgqj', p_c, overlap)
        cur = t // SLC_LEN
        valid = blk_ids[None, :] * SLC_LEN <= t[:, None]
        forced = (blk_ids[None, :] == 0) | (blk_ids[None, :] == cur[:, None]) | (blk_ids[None, :] == cur[:, None] - 1)
        score = jnp.where(valid, imp + FORCE_BONUS * forced.astype(jnp.float32), -jnp.inf)
        top_s, idx = lax.top_k(score, n_sel)
        k_sel = k_blk[bi, gi, idx]
        v_sel = v_blk[bi, gi, idx]
        pos = idx[..., None] * SLC_LEN + jnp.arange(SLC_LEN)
        dist = t[:, None, None] - pos
        mask_s = (jnp.isfinite(top_s)[..., None] & (dist >= 0))[:, :, None]
        s_s = jnp.einsum('bgrqe,bgqkle->bgrqkl', qb, k_sel).astype(jnp.float32) * ATTN_SCALE
        s_s = s_s - slopes[:, :, None, None, None] * dist[:, :, None].astype(jnp.float32)
        nk = n_sel * SLC_LEN
        p_s, _ = masked_softmax(s_s.reshape(B_, G, R, Q_BLOCK, nk), mask_s.reshape(B_, G, 1, Q_BLOCK, nk))
        o_s = jnp.einsum('bgrqn,bgqne->bgrqe', p_s, v_sel.reshape(B_, G, Q_BLOCK, nk, E))
        kw = lax.dynamic_slice_in_dim(k_win, t0, Q_BLOCK + WIN, axis=1)
        vw = lax.dynamic_slice_in_dim(v_win, t0, Q_BLOCK + WIN, axis=1)
        kpos = t0 - WIN + jnp.arange(Q_BLOCK + WIN)
        dw = t[:, None] - kpos[None, :]
        mask_w = (dw >= 0) & (dw < WIN) & (kpos[None, :] >= 0)
        s_w = jnp.einsum('bgrqe,bkge->bgrqk', qb, kw).astype(jnp.float32) * ATTN_SCALE
        s_w = s_w - slopes[:, :, None, None] * dw.astype(jnp.float32)
        p_w, _ = masked_softmax(s_w, mask_w)
        o_w = jnp.einsum('bgrqk,bkge->bgrqe', p_w, vw)
        o = gb[..., 0:1] * o_c + gb[..., 1:2] * o_s + gb[..., 2:3] * o_w
        return o.transpose(0, 3, 1, 2, 4).reshape(B_, Q_BLOCK, B_WIDTH)

    out = lax.map(one_block, jnp.arange(S_ // Q_BLOCK))
    return out.transpose(1, 0, 2, 3).reshape(B_, S_, B_WIDTH)


def hybrid_mixer(x, w_in, cmp_pos_k, cmp_w1_k, cmp_w2_k, cmp_pos_v, cmp_w1_v, cmp_w2_v,
                 w_branch_a, w_branch_b, w_out):
    u = x @ w_in
    split_idx = np.cumsum(IN_SIZES)[:-1].tolist()
    a_qkv, b_q, b_kv, b_gate, m_gate = jnp.split(u, split_idx, axis=-1)
    y_a = dilated_mixer(a_qkv)
    y_b = nsa_mixer(b_q, b_kv, b_gate, cmp_pos_k, cmp_w1_k, cmp_w2_k, cmp_pos_v, cmp_w1_v, cmp_w2_v)
    g_a, g_b = jnp.split(jax.nn.sigmoid(m_gate), 2, axis=-1)
    merged = g_a * (y_a @ w_branch_a) + g_b * (y_b @ w_branch_b)
    return merged @ w_out


def hier_moe(h, w_coarse, b_coarse, w_fine, b_fine, w_gate_up, w_down):
    B_, S_, D = h.shape
    T = B_ * S_
    xt = h.reshape(T, D)
    lg = (xt @ w_coarse).astype(jnp.float32) + b_coarse
    grp = jnp.argmax(lg, axis=-1)
    p_grp = jnp.take_along_axis(jax.nn.softmax(lg, axis=-1), grp[:, None], axis=-1)
    lf = jnp.einsum('td,gde->tge', xt, w_fine).astype(jnp.float32) + b_fine
    lf = jnp.take_along_axis(lf, grp[:, None, None], axis=1)[:, 0]
    top_v, top_i = lax.top_k(lf, MOE_TOP_K)
    weights = p_grp * jax.nn.softmax(top_v, axis=-1)
    expert = grp[:, None] * EXP_PER_GROUP + top_i
    n_assign = T * MOE_TOP_K
    e_flat = expert.reshape(n_assign)
    w_flat = weights.reshape(n_assign)
    tok = jnp.arange(n_assign) // MOE_TOP_K
    order = jnp.argsort(e_flat)
    e_s, tok_s, w_s = e_flat[order], tok[order], w_flat[order]
    counts = jnp.zeros((N_EXPERTS,), jnp.int32).at[e_flat].add(1)
    starts = jnp.cumsum(counts) - counts
    pcounts = (counts + MOE_BLOCK - 1) // MOE_BLOCK * MOE_BLOCK
    pends = jnp.cumsum(pcounts)
    pstarts = pends - pcounts
    dest = pstarts[e_s] + (jnp.arange(n_assign) - starts[e_s])
    P = -(-(n_assign + N_EXPERTS * (MOE_BLOCK - 1)) // MOE_BLOCK) * MOE_BLOCK
    nb = P // MOE_BLOCK
    tok_buf = jnp.full((P,), T, jnp.int32).at[dest].set(tok_s.astype(jnp.int32))
    w_buf = jnp.zeros((P,), jnp.float32).at[dest].set(w_s)
    blk_e = jnp.minimum(jnp.searchsorted(pends, jnp.arange(nb) * MOE_BLOCK, side='right'), N_EXPERTS - 1)
    x_pad = jnp.concatenate([xt, jnp.zeros((1, D), xt.dtype)], axis=0)
    xb = x_pad[tok_buf].reshape(nb, MOE_BLOCK, D)

    def expert_block(args):
        xblk, e = args
        g, u = jnp.split(xblk @ w_gate_up[e], 2, axis=-1)
        return (jax.nn.silu(g) * u) @ w_down[e]

    yb = lax.map(expert_block, (xb, blk_e)).reshape(P, D)
    y = jax.ops.segment_sum(yb * w_buf[:, None], tok_buf, num_segments=T + 1)[:T]
    return y.reshape(B_, S_, D).astype(h.dtype)


def setup_inputs(seed: int = 0) -> dict:
    key = jax.random.key(seed)
    ks = jax.random.split(key, 22)
    L, D, E = DEPTH, D_MODEL, HEAD_DIM

    def nrm(k, shape, scale):
        return jax.random.normal(k, shape, jnp.float32) * scale

    col_scale = np.ones((IN_COLS,), np.float32)
    col_scale[2 * A_WIDTH:3 * A_WIDTH] = BETA
    kv_off = 3 * A_WIDTH + B_WIDTH
    for i in (1, 3, 5):
        col_scale[kv_off + i * B_KV_WIDTH:kv_off + (i + 1) * B_KV_WIDTH] = BETA
    return {
        'x': nrm(ks[0], (BATCH, SEQ, D), 1.0),
        'w_in': nrm(ks[1], (L, D, IN_COLS), D ** -0.5) * jnp.asarray(col_scale),
        'cmp_pos_k': nrm(ks[2], (L, CMP_LEN, E), 0.5),
        'cmp_w1_k': nrm(ks[3], (L, CMP_LEN * E, CMP_HIDDEN), (CMP_LEN * E) ** -0.5),
        'cmp_w2_k': nrm(ks[4], (L, CMP_HIDDEN, E), CMP_HIDDEN ** -0.5),
        'cmp_pos_v': nrm(ks[5], (L, CMP_LEN, E), 0.5),
        'cmp_w1_v': nrm(ks[6], (L, CMP_LEN * E, CMP_HIDDEN), (CMP_LEN * E) ** -0.5),
        'cmp_w2_v': nrm(ks[7], (L, CMP_HIDDEN, E), CMP_HIDDEN ** -0.5),
        'w_branch_a': nrm(ks[8], (L, A_OUT, D), A_OUT ** -0.5),
        'w_branch_b': nrm(ks[9], (L, B_WIDTH, D), B_WIDTH ** -0.5),
        'w_out': nrm(ks[10], (L, D, D), BETA * D ** -0.5),
        'ln1_g': 1.0 + nrm(ks[11], (L, D), 0.02),
        'ln1_b': nrm(ks[12], (L, D), 0.02),
        'w_coarse': nrm(ks[13], (L, D, N_GROUPS), D ** -0.5),
        'b_coarse': nrm(ks[14], (L, N_GROUPS), 0.01),
        'w_fine': nrm(ks[15], (L, N_GROUPS, D, EXP_PER_GROUP), D ** -0.5),
        'b_fine': nrm(ks[16], (L, N_GROUPS, EXP_PER_GROUP), 0.01),
        'w_gate_up': nrm(ks[17], (L, N_EXPERTS, D, 2 * D_EXPERT), D ** -0.5),
        'w_down': nrm(ks[18], (L, N_EXPERTS, D_EXPERT, D), BETA * D_EXPERT ** -0.5),
        'ln2_g': 1.0 + nrm(ks[19], (L, D), 0.02),
        'ln2_b': nrm(ks[20], (L, D), 0.02),
    }


def reference(x, w_in, cmp_pos_k, cmp_w1_k, cmp_w2_k, cmp_pos_v, cmp_w1_v, cmp_w2_v,
              w_branch_a, w_branch_b, w_out, ln1_g, ln1_b,
              w_coarse, b_coarse, w_fine, b_fine, w_gate_up, w_down, ln2_g, ln2_b):
    h = x
    for l in range(DEPTH):
        mix = hybrid_mixer(h, w_in[l], cmp_pos_k[l], cmp_w1_k[l], cmp_w2_k[l],
                           cmp_pos_v[l], cmp_w1_v[l], cmp_w2_v[l],
                           w_branch_a[l], w_branch_b[l], w_out[l])
        h = layer_norm(ALPHA * h + mix, ln1_g[l], ln1_b[l])
        ffn = hier_moe(h, w_coarse[l], b_coarse[l], w_fine[l], b_fine[l], w_gate_up[l], w_down[l])
        h = layer_norm(ALPHA * h + ffn, ln2_g[l], ln2_b[l])
    return h
```

```cpp
#include <hip/hip_runtime.h>
#include <hip/hip_cooperative_groups.h>
#include <cstdio>
#include <cstdint>
namespace cg = cooperative_groups;

#ifndef ONE_LAUNCH
#define ONE_LAUNCH 1
#endif

typedef unsigned short bf16_t;

constexpr int NB = 4, S = 8192, T = NB * S, D = 1024;
constexpr int INC = 5656;
constexpr int C_BQ = 2304, C_BKV = 2816, C_BG = 3584, C_MG = 3608;
constexpr int NEXP = 32, DEXP = 512;
constexpr float ALPHA = 1.189207115002721f;
constexpr float LN_EPS = 1e-5f;
constexpr float TINY = 1e-30f;
constexpr int NTHREADS = 512, NWAVES = 8;

constexpr size_t MiB = (size_t)1 << 20;
constexpr size_t KiB = 1024;
constexpr size_t O_WINT = 0;
constexpr size_t O_WBAT = 12 * MiB;
constexpr size_t O_WBBT = 12 * MiB + 512 * KiB;
constexpr size_t O_WOUTT = 13 * MiB + 512 * KiB;
constexpr size_t O_WC1KT = 15 * MiB + 512 * KiB;
constexpr size_t O_WC1VT = 16 * MiB + 512 * KiB;
constexpr size_t O_XB = 18 * MiB;
constexpr size_t O_H1B = 18 * MiB;
constexpr size_t O_OG = 18 * MiB;
constexpr size_t O_LSE = 66 * MiB;
constexpr size_t O_MG = 82 * MiB;
constexpr size_t O_WGUT = 82 * MiB;
constexpr size_t O_WDT = 146 * MiB;
constexpr size_t O_QA = 210 * MiB;
constexpr size_t O_KA = 258 * MiB;
constexpr size_t O_VAT = 306 * MiB;
constexpr size_t O_YB = 210 * MiB;
constexpr size_t O_YAB = 306 * MiB;
constexpr size_t O_MERGED = 242 * MiB;
constexpr size_t O_YE = 210 * MiB;
constexpr size_t O_XG = 210 * MiB;
constexpr size_t O_BQ = 354 * MiB;
constexpr size_t O_ACT = 354 * MiB;
constexpr size_t O_CK = 386 * MiB;
constexpr size_t O_CV = 394 * MiB;
constexpr size_t O_SK = 402 * MiB;
constexpr size_t O_SVT = 410 * MiB;
constexpr size_t O_WK = 418 * MiB;
constexpr size_t O_WVT = 426 * MiB;
constexpr size_t O_BG = 434 * MiB;
constexpr size_t O_KC = 437 * MiB;
constexpr size_t O_VCT = 437 * MiB + 512 * KiB;
constexpr size_t O_YA = 438 * MiB;
constexpr size_t O_HID = 454 * MiB;
constexpr size_t O_LIST = 462 * MiB;
constexpr size_t O_WTS = 466 * MiB;
constexpr size_t O_CNT = 467 * MiB;
constexpr size_t O_WC2T = 17 * MiB + 512 * KiB;
constexpr size_t O_WRT = 17 * MiB + 768 * KiB;
constexpr size_t O_CB = 17 * MiB + 1000 * KiB;
constexpr size_t O_H1L = 210 * MiB;
constexpr size_t O_ES = 468 * MiB;
constexpr size_t WS_NEED = 469 * MiB;
constexpr int PMAX = 2 * T + NEXP * 255;
static_assert(O_WINT + (size_t)5888 * 1024 * 2 <= O_WBAT && O_WBAT + 1024 * 256 * 2 <= O_WBBT && O_WBBT + 1024 * 512 * 2 <= O_WOUTT && O_WOUTT + 1024 * 1024 * 2 <= O_WC1KT &&
              O_WC1KT + 256 * 2048 * 2 <= O_WC1VT && O_WC1VT + 256 * 2048 * 2 <= O_XB && O_XB + (size_t)T * 1024 * 2 <= O_MG && O_MG + (size_t)T * 2048 * 2 <= O_QA &&
              O_VAT + 48 * MiB <= O_BQ && O_BQ + 32 * MiB <= O_CK && O_WVT + 8 * MiB <= O_BG && O_BG + (size_t)T * 24 * 4 <= O_KC && O_VCT + 512 * KiB <= O_YA && O_YA + 16 * MiB <= O_HID &&
              O_HID + 8 * MiB <= O_LIST && O_LIST + 4 * MiB <= O_WTS && O_WTS + (size_t)2 * T * 4 <= O_CNT, "ws map");
constexpr int NPAD_IN = 5888;
constexpr int LDS_BYTES = 163840;

struct Params {
    const float *x, *w_in, *cmp_pos_k, *cmp_w1_k, *cmp_w2_k, *cmp_pos_v, *cmp_w1_v, *cmp_w2_v, *w_br_a, *w_br_b, *w_out,
        *ln1_g, *ln1_b, *w_coarse, *b_coarse, *w_fine, *b_fine, *w_gate_up, *w_down, *ln2_g, *ln2_b;
    float* out;
    unsigned char* ws;
    int wbase, pad_;
};

__device__ __forceinline__ Params get_params(int wbase) {
    const volatile unsigned long long* kp = (const volatile unsigned long long*)__builtin_amdgcn_kernarg_segment_ptr();
    Params q; unsigned long long* qd = (unsigned long long*)&q;
#pragma unroll
    for (int k = 0; k < 23; ++k) { const unsigned long long v = kp[k]; qd[k] = ((unsigned long long)(unsigned)__builtin_amdgcn_readfirstlane((int)(v >> 32)) << 32) | (unsigned)__builtin_amdgcn_readfirstlane((int)v); }
    q.wbase = wbase; q.pad_ = 0;
    return q;
}
__device__ __forceinline__ int opq_tid(int wbase) { int t; asm volatile("v_mbcnt_lo_u32_b32 %0, -1, 0\n\tv_mbcnt_hi_u32_b32 %0, -1, %0" : "=v"(t)); return wbase + t; }
__device__ __forceinline__ int opq_bid() { int b = blockIdx.x; asm volatile("" : "+s"(b)); return b; }
__device__ __forceinline__ int opq_grid() { int b = gridDim.x; asm volatile("" : "+s"(b)); return b; }
__device__ __forceinline__ float bf2f(bf16_t v) { return __uint_as_float(((unsigned)v) << 16); }
__device__ __forceinline__ bf16_t f2bf(float f) { unsigned u = __float_as_uint(f); return (bf16_t)((u + 0x7fffu + ((u >> 16) & 1u)) >> 16); }
__device__ __forceinline__ float ldf(const float* p) { return *p; }
__device__ __forceinline__ float ldf(const bf16_t* p) { return bf2f(*p); }
__device__ __forceinline__ float sigmoid_(float v) { return 1.f / (1.f + expf(-v)); }
__device__ __forceinline__ float wave_sum(float v) {
#pragma unroll
    for (int o = 1; o < 64; o <<= 1) v += __shfl_xor(v, o);
    return v;
}
__device__ __forceinline__ float wave_max(float v) {
#pragma unroll
    for (int o = 1; o < 64; o <<= 1) v = fmaxf(v, __shfl_xor(v, o));
    return v;
}
template <int N> __device__ __forceinline__ void tr_step(float (&v)[64], int lane) {
    constexpr int H = N / 2;
    const bool up = (lane & H) != 0;
#pragma unroll
    for (int i = 0; i < H; ++i) {
        const float keep = up ? v[i + H] : v[i];
        const float send = up ? v[i] : v[i + H];
        v[i] = keep + __shfl_xor(send, H);
    }
}
template <int N> __device__ __forceinline__ void tr_step32(float (&v)[32], int lane) {
    constexpr int H = N / 2;
    const bool up = (lane & H) != 0;
#pragma unroll
    for (int i = 0; i < H; ++i) {
        const float keep = up ? v[i + H] : v[i];
        const float send = up ? v[i] : v[i + H];
        v[i] = keep + __shfl_xor(send, H);
    }
}
__device__ __forceinline__ float tr_reduce32(float (&v)[32], int lane) {
    tr_step32<32>(v, lane); tr_step32<16>(v, lane); tr_step32<8>(v, lane); tr_step32<4>(v, lane); tr_step32<2>(v, lane);
    return v[0] + __shfl_xor(v[0], 32);
}
__device__ __forceinline__ float tr_reduce64(float (&v)[64], int lane) {
    tr_step<64>(v, lane); tr_step<32>(v, lane); tr_step<16>(v, lane); tr_step<8>(v, lane); tr_step<4>(v, lane); tr_step<2>(v, lane);
    return v[0];
}

__device__ __forceinline__ float dot64(const float* q, const bf16_t* kr) {
    float s = 0.f;
#pragma unroll
    for (int c = 0; c < 8; ++c) {
        const uint4 u = *(const uint4*)(kr + c * 8);
        const float4 qa = *(const float4*)(q + c * 8), qb = *(const float4*)(q + c * 8 + 4);
        s += qa.x * __uint_as_float(u.x << 16) + qa.y * __uint_as_float(u.x & 0xffff0000u);
        s += qa.z * __uint_as_float(u.y << 16) + qa.w * __uint_as_float(u.y & 0xffff0000u);
        s += qb.x * __uint_as_float(u.z << 16) + qb.y * __uint_as_float(u.z & 0xffff0000u);
        s += qb.z * __uint_as_float(u.w << 16) + qb.w * __uint_as_float(u.w & 0xffff0000u);
    }
    return s;
}
__device__ __forceinline__ int dil_of(int g) { return g == 0 ? 1 : (g == 1 ? 4 : 16); }

__device__ __forceinline__ void store_u(const Params& p, int t, int c, float v) {
    unsigned char* ws = p.ws;
    const int b = t / S, s = t % S;
    if (c < C_BQ) {
        const int which = c / 768, cc = c % 768, g = cc / 256, h = (cc % 256) / 64, e = cc % 64;
        const int d = dil_of(g), L = S / d, ps = (s % d) * L + s / d;
        const size_t base = (size_t)((b * 3 + g) * 4 + h);
        if (which == 0) ((bf16_t*)(ws + O_QA))[(base * S + ps) * 64 + e] = f2bf(v);
        else if (which == 1) ((bf16_t*)(ws + O_KA))[(base * S + ps) * 64 + e] = f2bf(v);
        else ((bf16_t*)(ws + O_VAT))[(base * 64 + e) * S + ps] = f2bf(v);
    } else if (c < C_BKV) {
        ((bf16_t*)(ws + O_BQ))[(size_t)t * 512 + (c - C_BQ)] = f2bf(v);
    } else if (c < C_BG) {
        const int cc = c - C_BKV, i = cc / 128, g = (cc % 128) / 64, e = cc % 64;
        const size_t bg = (size_t)(b * 2 + g);
        const bf16_t bv = f2bf(v);
        if (i == 0) ((bf16_t*)(ws + O_CK))[(bg * S + s) * 64 + e] = bv;
        else if (i == 1) ((bf16_t*)(ws + O_CV))[(bg * S + s) * 64 + e] = bv;
        else if (i == 2) ((bf16_t*)(ws + O_SK))[(bg * S + s) * 64 + e] = bv;
        else if (i == 3) ((bf16_t*)(ws + O_SVT))[(bg * 64 + e) * S + s] = bv;
        else if (i == 4) ((bf16_t*)(ws + O_WK))[(bg * S + s) * 64 + e] = bv;
        else ((bf16_t*)(ws + O_WVT))[(bg * 64 + e) * S + s] = bv;
    } else if (c < C_MG) {
        ((float*)(ws + O_BG))[(size_t)t * 24 + (c - C_BG)] = sigmoid_(v);
    } else {
        ((bf16_t*)(ws + O_MG))[(size_t)t * 2048 + (c - C_MG)] = f2bf(sigmoid_(v));
    }
}

template <typename TA, typename TB>
__device__ __forceinline__ void sgemm_tile(float (&acc)[4][8], const TA* arow, const float* aadd, const TB* Bp, int ldb, int ncv, int K, float* lds, int tid) {
    float* As = lds; float* Bs = lds + 16 * 132;
    const int tx = tid & 15, ty = tid >> 4;
    const int ar = tid >> 2, ak = (tid & 3) * 4;
    const int bk = tid >> 5, bc = (tid & 31) * 4;
#pragma unroll 1
    for (int k0 = 0; k0 < K; k0 += 16) {
        float av[4], bv[4];
#pragma unroll
        for (int j = 0; j < 4; ++j) {
            av[j] = arow ? ldf(arow + k0 + ak + j) : 0.f;
            if (aadd) av[j] += aadd[k0 + ak + j];
            bv[j] = (bc + j < ncv) ? ldf(Bp + (size_t)(k0 + bk) * ldb + bc + j) : 0.f;
        }
        __syncthreads();
#pragma unroll
        for (int j = 0; j < 4; ++j) { As[(ak + j) * 132 + ar] = av[j]; Bs[bk * 128 + bc + j] = bv[j]; }
        __syncthreads();
#pragma unroll
        for (int kk = 0; kk < 16; ++kk) {
            float a[4], b[8];
#pragma unroll
            for (int i = 0; i < 4; ++i) a[i] = As[kk * 132 + ty * 4 + i];
#pragma unroll
            for (int j = 0; j < 8; ++j) b[j] = Bs[kk * 128 + tx * 8 + j];
#pragma unroll
            for (int i = 0; i < 4; ++i)
#pragma unroll
                for (int j = 0; j < 8; ++j) acc[i][j] += a[i] * b[j];
            if ((kk & 3) == 3) asm volatile("" ::: "memory");
        }
    }
    __syncthreads();
}
__device__ __forceinline__ void zero_acc(float (&acc)[4][8]) {
#pragma unroll
    for (int i = 0; i < 4; ++i)
#pragma unroll
        for (int j = 0; j < 8; ++j) acc[i][j] = 0.f;
}

template <class KF>
__device__ __forceinline__ void attend_naive(const float* q, int nkeys, int vstride, KF kf, int lane, float& o_out, float& lse_out) {
    float m = -INFINITY;
    for (int i0 = 0; i0 < nkeys; i0 += 64) {
        const int i = i0 + lane;
        const bf16_t* kr = nullptr; const bf16_t* vc = nullptr; float bias = 0.f;
        const bool valid = (i < nkeys) && kf(i, kr, vc, bias);
        if (valid) {
            float s = dot64(q, kr);
            s = s * 0.125f + bias;
            m = fmaxf(m, s);
        }
    }
    m = wave_max(m);
    if (!(m > -INFINITY)) m = 0.f;
    float l = 0.f, ohalf[2];
#pragma unroll 1
    for (int half = 0; half < 2; ++half) {
        float op[32];
#pragma unroll
        for (int d = 0; d < 32; ++d) op[d] = 0.f;
        l = 0.f;
        for (int i0 = 0; i0 < nkeys; i0 += 64) {
            const int i = i0 + lane;
            const bf16_t* kr = nullptr; const bf16_t* vc = nullptr; float bias = 0.f;
            const bool valid = (i < nkeys) && kf(i, kr, vc, bias);
            if (valid) {
                float s = dot64(q, kr);
                s = s * 0.125f + bias;
                const float pe = expf(s - m);
                l += pe;
                const bf16_t* vh = vc + (size_t)(half * 32) * vstride;
#pragma unroll
                for (int d = 0; d < 32; ++d) op[d] += pe * bf2f(vh[(size_t)d * vstride]);
            }
        }
        const float r = tr_reduce32(op, lane);
        if (half == 0) ohalf[0] = r; else ohalf[1] = r;
    }
    l = wave_sum(l);
    const float o = lane < 32 ? ohalf[0] : ohalf[1];
    o_out = o / fmaxf(l, TINY);
    lse_out = m + logf(l);
}

namespace pg8 {
#define PG8_LAS __attribute__((address_space(3)))
typedef unsigned short bf16_t;
typedef short bf16x8 __attribute__((ext_vector_type(8)));
typedef float f32x4 __attribute__((ext_vector_type(4)));
typedef unsigned u32x4 __attribute__((ext_vector_type(4)));
constexpr int BM = 256, BK = 64, HALF = 128, HTB = HALF * BK * 2  , STAGE_BYTES = 8 * HTB, NXCD = 8, WGM = 8;

__host__ __device__ __forceinline__ int lds_byte(int r, int c) { const int st = (r >> 4) * 2 + (c >> 5), rr = r & 15, cc = c & 31, ob = rr * 64 + cc * 2; return st * 1024 + (ob ^ (((ob >> 9) & 1) << 5)); }
__host__ __device__ __forceinline__ void stage_rc(int b, int& R, int& C) { const int st = b / 1024, sb = b % 1024, swz = sb ^ (((sb >> 9) & 1) << 5); R = (st >> 1) * 16 + swz / 64; C = (st & 1) * 32 + (swz % 64) / 2; }
__host__ __device__ __forceinline__ int perm32(int rho) { const int n = rho >> 4, i = rho & 15; return 8 * (i >> 2) + 4 * n + (i & 3); }


struct Unit { int pm, pn; const char* a; const char* b; const int* rows; int nrows; };
struct Gemm { int K, lda, wbase; };
__device__ __forceinline__ const char* uni_ptr(const char* p) { const unsigned long long v = (unsigned long long)p; const unsigned lo = (unsigned)__builtin_amdgcn_readfirstlane((int)(unsigned)v), hi = (unsigned)__builtin_amdgcn_readfirstlane((int)(unsigned)(v >> 32)); return (const char*)(((unsigned long long)hi << 32) | lo); }
typedef float f32x2_t __attribute__((ext_vector_type(2))); typedef __bf16 bf16x2_t __attribute__((ext_vector_type(2)));
__device__ __forceinline__ unsigned cvt_pk_bf16(float lo, float hi) { f32x2_t v = {lo, hi}; bf16x2_t b = __builtin_convertvector(v, bf16x2_t); return __builtin_bit_cast(unsigned, b); }
template <class Epi, class Sched, bool ALIGN_EPI = false, bool SP2 = false, bool GATHER = false>
__device__ __forceinline__ void gemm_phase(PG8_LAS unsigned char* lds, const Gemm g, const Sched& S, const Epi& E) {
    const int tid = opq_tid(g.wbase), wid = __builtin_amdgcn_readfirstlane(tid >> 6), lane = tid & 63, wr = wid >> 2, wc = wid & 3, fr = lane & 15, fq = lane >> 4;
    int Kq = g.K; asm volatile("" : "+s"(Kq));
    const int K = Kq, nt = K / BK;
    unsigned voffA[2], voffB[2];
#pragma unroll
    for (int i = 0; i < 2; ++i) { int R, C; stage_rc(tid * 16 + i * 8192, R, C); const int Rb = Epi::PERM ? ((R & ~31) + perm32(R & 31)) : R;
        voffA[i] = (unsigned)(R * g.lda + C) * 2u; voffB[i] = (unsigned)(Rb * K + C) * 2u; }
    const size_t kstep = (size_t)(BK * 2);
    const size_t hstepA = (size_t)HALF * g.lda * 2, hstepB = (size_t)HALF * K * 2;
    const unsigned ldsw = (unsigned)wid * 1024u;
    const int aoff = lds_byte(wr * 64 + fr, fq * 8), boff = lds_byte(wc * 32 + fr, fq * 8);
#define PG8_SA(b, h) (((b) * 2 + (h)) * HTB)
#define PG8_SB(b, h) ((4 + (b) * 2 + (h)) * HTB)
#define PG8_STAGE(bufoff, gbase, voff) do { _Pragma("unroll") for (int _i = 0; _i < 2; ++_i) \
        __builtin_amdgcn_global_load_lds((const unsigned*)((const char*)(gbase) + (voff)[_i]), (PG8_LAS unsigned*)(lds + (bufoff) + ldsw + _i * 8192), 16, 0, 0); } while (0)
#define PG8_STAGE_A(b_, h_, ptr_, nsel_) do { if constexpr (GATHER) { const unsigned pk_ = (nsel_) ? nvg[h_] : cvg[h_]; unsigned vo_[2]; vo_[0] = (pk_ & 0xffffu) * (unsigned)(g.lda * 2) + gcol[0]; vo_[1] = (pk_ >> 16) * (unsigned)(g.lda * 2) + gcol[1]; PG8_STAGE(PG8_SA(b_, h_), ptr_, vo_); } \
        else { PG8_STAGE(PG8_SA(b_, h_), (ptr_) + (h_) * hstepA, voffA); } } while (0)
#define PG8_LDA(dst, b, h) do { _Pragma("unroll") for (int m = 0; m < 4; ++m) _Pragma("unroll") for (int k = 0; k < 2; ++k) dst[m][k] = *(const PG8_LAS bf16x8*)(lds + PG8_SA(b, h) + aoff + m * 2048 + k * 1024); } while (0)
#define PG8_LDB(dst, b, h) do { _Pragma("unroll") for (int n = 0; n < 2; ++n) _Pragma("unroll") for (int k = 0; k < 2; ++k) dst[n][k] = *(const PG8_LAS bf16x8*)(lds + PG8_SB(b, h) + boff + n * 2048 + k * 1024); } while (0)
#define PG8_MMA(ai, bj, At, Bt) do { __builtin_amdgcn_s_setprio(1); _Pragma("unroll") for (int m = 0; m < 4; ++m) _Pragma("unroll") for (int n = 0; n < 2; ++n) _Pragma("unroll") for (int k = 0; k < 2; ++k) \
        acc[ai][bj][m][n] = __builtin_amdgcn_mfma_f32_16x16x32_bf16(Bt[n][k], At[m][k], acc[ai][bj][m][n], 0, 0, 0); __builtin_amdgcn_s_setprio(0); } while (0)
#define PG8_WAIT_V(n) asm volatile("s_waitcnt vmcnt(" #n ")" ::: "memory")
#define PG8_WAIT_L(n) asm volatile("s_waitcnt lgkmcnt(" #n ")" ::: "memory")
#define PG8_BAR __builtin_amdgcn_s_barrier()
#define PG8_SCHED __builtin_amdgcn_sched_barrier(0)
    Unit cur, nxt; int ui = 0;
    if (!S.next(0, cur)) return;
    unsigned gcol[2]; { int R_, C_; stage_rc(tid * 16, R_, C_); gcol[0] = (unsigned)C_ * 2u; stage_rc(tid * 16 + 8192, R_, C_); gcol[1] = (unsigned)C_ * 2u; }
    unsigned cvg[2] = {0u, 0u}, nvg[2] = {0u, 0u};
    auto calc_vg = [&](const Unit& u_, unsigned (&vg_)[2]) {
#pragma unroll
        for (int h_ = 0; h_ < 2; ++h_) {
            unsigned pk_ = 0u;
#pragma unroll
            for (int i_ = 0; i_ < 2; ++i_) { int R_, C_; stage_rc(tid * 16 + i_ * 8192, R_, C_); const int idx_ = h_ * HALF + R_; const unsigned tok_ = idx_ < u_.nrows ? (unsigned)(u_.rows[idx_] >> 1) : 0u; pk_ |= tok_ << (16 * i_); }
            vg_[h_] = pk_;
        }
    };
    if constexpr (GATHER) calc_vg(cur, cvg);
    f32x4 acc[2][2][4][2];
#pragma unroll
    for (int a = 0; a < 2; ++a)
#pragma unroll
        for (int b = 0; b < 2; ++b)
#pragma unroll
            for (int m = 0; m < 4; ++m)
#pragma unroll
                for (int n = 0; n < 2; ++n) acc[a][b][m][n] = (f32x4){0.f, 0.f, 0.f, 0.f};
    bf16x8 At[4][2], B0[2][2], B1[2][2];
    const char* cA = uni_ptr(cur.a); const char* cB = uni_ptr(cur.b);
    S.a_ready(cur);
    if constexpr (SP2) {
        PG8_STAGE(PG8_SB(0, 0), cB, voffB); PG8_STAGE(PG8_SB(0, 1), cB + hstepB, voffB); PG8_STAGE_A(0, 0, cA, false); PG8_STAGE_A(0, 1, cA, false);
        if (wr == 1) PG8_BAR;
        PG8_WAIT_V(2); PG8_BAR;
        PG8_STAGE(PG8_SB(1, 0), cB + kstep, voffB); PG8_STAGE_A(1, 0, cA + kstep, false); PG8_STAGE(PG8_SB(1, 1), cB + hstepB + kstep, voffB);
        PG8_WAIT_V(6); PG8_BAR;
    } else {
        PG8_STAGE(PG8_SB(0, 0), cB, voffB); PG8_STAGE_A(0, 0, cA, false); PG8_STAGE(PG8_SB(0, 1), cB + hstepB, voffB); PG8_STAGE_A(0, 1, cA, false);
        if (wr == 1) PG8_BAR;
        PG8_WAIT_V(4); PG8_BAR;
        PG8_STAGE(PG8_SB(1, 0), cB + kstep, voffB); PG8_STAGE_A(1, 0, cA + kstep, false); PG8_STAGE(PG8_SB(1, 1), cB + hstepB + kstep, voffB);
        PG8_WAIT_V(6); PG8_BAR;
    }
    for (;;) {
        const bool has_next = S.next(ui + 1, nxt);
        const char* nA = uni_ptr(has_next ? nxt.a : cA); const char* nB = uni_ptr(has_next ? nxt.b : cB);
        if constexpr (GATHER) { if (has_next) calc_vg(nxt, nvg); else { nvg[0] = cvg[0]; nvg[1] = cvg[1]; } }
        for (int t = 0; t < nt; t += 2) {
            const bool last = (t == nt - 2);
            const char* a1 = cA + (size_t)(t + 1) * kstep;
            const char* a2 = last ? nA : cA + (size_t)(t + 2) * kstep; const char* b2 = last ? nB : cB + (size_t)(t + 2) * kstep;
            const char* a3 = a2 + kstep; const char* b3 = b2 + kstep;
            if (last && has_next) S.a_ready(nxt);
            if constexpr (Epi::MID_T > 0) { if (t == Epi::MID_T) E.mid(acc, cur, wr, wc, fr, fq); }
            if constexpr (SP2) {
            PG8_LDB(B0, 0, 0); PG8_LDB(B1, 0, 1); PG8_SCHED; PG8_LDA(At, 0, 0); PG8_STAGE_A(1, 1, a1, false);
            PG8_WAIT_V(8); PG8_WAIT_L(0); PG8_BAR; PG8_MMA(0, 0, At, B0); PG8_MMA(0, 1, At, B1); PG8_BAR; PG8_SCHED;
            PG8_LDA(At, 0, 1); PG8_STAGE(PG8_SB(0, 0), b2, voffB); PG8_STAGE(PG8_SB(0, 1), b2 + hstepB, voffB); PG8_STAGE_A(0, 0, a2, last);
            PG8_WAIT_V(8); PG8_WAIT_L(0); PG8_BAR; PG8_MMA(1, 0, At, B0); PG8_MMA(1, 1, At, B1); PG8_BAR; PG8_SCHED;
            PG8_LDB(B0, 1, 0); PG8_LDB(B1, 1, 1); PG8_SCHED; PG8_LDA(At, 1, 0); PG8_STAGE_A(0, 1, a2, last);
            PG8_WAIT_V(8); PG8_WAIT_L(0); PG8_BAR; PG8_MMA(0, 0, At, B0); PG8_MMA(0, 1, At, B1); PG8_BAR; PG8_SCHED;
            PG8_LDA(At, 1, 1); PG8_STAGE(PG8_SB(1, 0), b3, voffB); PG8_STAGE(PG8_SB(1, 1), b3 + hstepB, voffB); PG8_STAGE_A(1, 0, a3, last);
            PG8_WAIT_V(8); PG8_WAIT_L(0); PG8_BAR; PG8_MMA(1, 0, At, B0); PG8_MMA(1, 1, At, B1); PG8_BAR; PG8_SCHED;
            } else {
            PG8_LDB(B0, 0, 0); PG8_SCHED; PG8_LDA(At, 0, 0); PG8_STAGE_A(1, 1, a1, false);
            PG8_WAIT_L(8); PG8_BAR; PG8_WAIT_L(0); PG8_MMA(0, 0, At, B0); PG8_BAR; PG8_SCHED;
            PG8_LDB(B1, 0, 1); PG8_STAGE(PG8_SB(0, 0), b2, voffB);
            PG8_BAR; PG8_WAIT_L(0); PG8_MMA(0, 1, At, B1); PG8_BAR;
            PG8_LDA(At, 0, 1); PG8_STAGE_A(0, 0, a2, last);
            PG8_BAR; PG8_WAIT_L(0); PG8_MMA(1, 0, At, B0); PG8_BAR; PG8_SCHED;
            PG8_STAGE(PG8_SB(0, 1), b2 + hstepB, voffB);
            PG8_WAIT_V(6); PG8_BAR; PG8_MMA(1, 1, At, B1); PG8_BAR;
            PG8_LDB(B0, 1, 0); PG8_SCHED; PG8_LDA(At, 1, 0); PG8_STAGE_A(0, 1, a2, last);
            PG8_WAIT_L(8); PG8_BAR; PG8_WAIT_L(0); PG8_MMA(0, 0, At, B0); PG8_BAR; PG8_SCHED;
            PG8_LDB(B1, 1, 1); PG8_STAGE(PG8_SB(1, 0), b3, voffB);
            PG8_BAR; PG8_WAIT_L(0); PG8_MMA(0, 1, At, B1); PG8_BAR;
            PG8_LDA(At, 1, 1); PG8_STAGE_A(1, 0, a3, last);
            PG8_BAR; PG8_WAIT_L(0); PG8_MMA(1, 0, At, B0); PG8_BAR; PG8_SCHED;
            PG8_STAGE(PG8_SB(1, 1), b3 + hstepB, voffB);
            PG8_WAIT_V(6); PG8_BAR; PG8_MMA(1, 1, At, B1); PG8_BAR;
            }
        }
        if constexpr (ALIGN_EPI) { if (wr == 0) PG8_BAR; }
        if constexpr (!Epi::AFTER_DRAIN) { E(acc, cur, wr, wc, fr, fq); S.done(cur); }
        if (!has_next) break;
#pragma unroll
        for (int a = 0; a < 2; ++a)
#pragma unroll
            for (int b = 0; b < 2; ++b)
#pragma unroll
                for (int m = 0; m < 4; ++m)
#pragma unroll
                    for (int n = 0; n < 2; ++n) acc[a][b][m][n] = (f32x4){0.f, 0.f, 0.f, 0.f};
        cur = nxt; cA = nA; cB = nB; ++ui;
        if constexpr (GATHER) { cvg[0] = nvg[0]; cvg[1] = nvg[1]; }
        if constexpr (ALIGN_EPI) { if (wr == 1) PG8_BAR; }
    }
    PG8_WAIT_V(0);
    if constexpr (!ALIGN_EPI) { if (wr == 0) PG8_BAR; }
    PG8_BAR;
    if constexpr (Epi::AFTER_DRAIN) { E.fused(acc, cur, wr, wc, fr, fq, lds, wid, lane); S.done(cur); }
#undef PG8_SA
#undef PG8_SB
#undef PG8_STAGE
#undef PG8_STAGE_A
#undef PG8_LDA
#undef PG8_LDB
#undef PG8_MMA
#undef PG8_WAIT_V
#undef PG8_WAIT_L
#undef PG8_BAR
#undef PG8_SCHED
}
}

#define LAS __attribute__((address_space(3)))
typedef unsigned v4u __attribute__((ext_vector_type(4)));
typedef float f32x4 __attribute__((ext_vector_type(4)));

struct TileOrder {
    int nM, nN, nwg, G, c; const char* A; const char* Bt; size_t tstepA, tstepB;
    __device__ __forceinline__ void init(const void* A_, const void* Bt_, int M, int N, int K, int lda, int G_, int c_) {
        nM = M / 256; nN = N / 256; nwg = nM * nN; G = G_; c = c_; A = (const char*)A_; Bt = (const char*)Bt_; tstepA = (size_t)256 * lda * 2; tstepB = (size_t)256 * K * 2; }
    __device__ __forceinline__ bool next(int i, pg8::Unit& u) const {
        const long L = (long)i * G + c; if (L >= nwg) return false;
        int wgid = (int)L; { const int q = nwg / 8, r = nwg % 8, xcd = wgid % 8, off = wgid / 8; wgid = (xcd < r ? xcd * (q + 1) : r * (q + 1) + (xcd - r) * q) + off; }
        const int nig = 8 * nN, gid = wgid / nig, fm = gid * 8, gsz = (nM - fm) < 8 ? (nM - fm) : 8;
        u.pm = fm + ((wgid % nig) % gsz); u.pn = (wgid % nig) / gsz; u.a = A + (size_t)u.pm * tstepA; u.b = Bt + (size_t)u.pn * tstepB; u.rows = nullptr; u.nrows = 0; return true;
    }
    __device__ __forceinline__ void a_ready(const pg8::Unit&) const {}
    __device__ __forceinline__ void done(const pg8::Unit&) const {}
};

constexpr float QK_C0 = 0.125f * 1.4426950408889634f;
__device__ __forceinline__ float fsigmoid(float v) { return __builtin_amdgcn_rcpf(1.f + __expf(-v)); }
__device__ __forceinline__ void store_u8(unsigned char* ws, int t, int c0, const f32x4 v0, const f32x4 v1) {
    if (c0 >= INC) return;
    const int b = t >> 13, s = t & (S - 1);
    if (c0 >= C_MG) {
        v4u w; w.x = pg8::cvt_pk_bf16(fsigmoid(v0[0]), fsigmoid(v0[1])); w.y = pg8::cvt_pk_bf16(fsigmoid(v0[2]), fsigmoid(v0[3]));
        w.z = pg8::cvt_pk_bf16(fsigmoid(v1[0]), fsigmoid(v1[1])); w.w = pg8::cvt_pk_bf16(fsigmoid(v1[2]), fsigmoid(v1[3]));
        *(v4u*)((bf16_t*)(ws + O_MG) + (size_t)t * 2048 + (c0 - C_MG)) = w;
        return;
    }
    if (c0 >= C_BG) {
        float* o = (float*)(ws + O_BG) + (size_t)t * 24 + (c0 - C_BG);
        *(f32x4*)o = (f32x4){fsigmoid(v0[0]), fsigmoid(v0[1]), fsigmoid(v0[2]), fsigmoid(v0[3])};
        *(f32x4*)(o + 4) = (f32x4){fsigmoid(v1[0]), fsigmoid(v1[1]), fsigmoid(v1[2]), fsigmoid(v1[3])};
        return;
    }
    const float qs = (c0 < 768 || (c0 >= C_BQ && c0 < C_BKV)) ? QK_C0 : 1.f;
    v4u w; w.x = pg8::cvt_pk_bf16(v0[0] * qs, v0[1] * qs); w.y = pg8::cvt_pk_bf16(v0[2] * qs, v0[3] * qs); w.z = pg8::cvt_pk_bf16(v1[0] * qs, v1[1] * qs); w.w = pg8::cvt_pk_bf16(v1[2] * qs, v1[3] * qs);
    bf16_t* tp = nullptr; bf16_t* rp = nullptr;
    if (c0 < C_BQ) {
        const int which = c0 / 768, cc = c0 - which * 768, g = cc >> 8, h = (cc >> 6) & 3, e0 = cc & 63, sh = 2 * g;
        const int ps = ((s & ((1 << sh) - 1)) << (13 - sh)) + (s >> sh);
        const size_t base = (size_t)((b * 3 + g) * 4 + h);
        if (which == 2) tp = (bf16_t*)(ws + O_VAT) + (base * 64 + e0) * S + ps;
        else rp = (bf16_t*)(ws + (which ? O_KA : O_QA)) + (base * S + ps) * 64 + e0;
    } else if (c0 < C_BKV) {
        rp = (bf16_t*)(ws + O_BQ) + (size_t)t * 512 + (c0 - C_BQ);
    } else {
        const int cc = c0 - C_BKV, i = cc >> 7, g = (cc >> 6) & 1, e0 = cc & 63; const size_t bg = (size_t)(b * 2 + g);
        bf16_t* buf = (bf16_t*)(ws + O_CK + (size_t)i * 8 * MiB);
        if (i == 3 || i == 5) tp = buf + (bg * 64 + e0) * S + s; else rp = buf + (bg * S + s) * 64 + e0;
    }
    if (rp) *(v4u*)rp = w;
    else {
        tp[0] = (bf16_t)(w.x & 0xffffu); tp[(size_t)S] = (bf16_t)(w.x >> 16); tp[(size_t)2 * S] = (bf16_t)(w.y & 0xffffu); tp[(size_t)3 * S] = (bf16_t)(w.y >> 16);
        tp[(size_t)4 * S] = (bf16_t)(w.z & 0xffffu); tp[(size_t)5 * S] = (bf16_t)(w.z >> 16); tp[(size_t)6 * S] = (bf16_t)(w.w & 0xffffu); tp[(size_t)7 * S] = (bf16_t)(w.w >> 16);
    }
}
__device__ __forceinline__ bool vspan(unsigned char* ws, int c0, int b, bf16_t*& dst, int& sh) {
    if (c0 >= 1536 && c0 < C_BQ) {
        const int cc = c0 - 1536, g = cc >> 8, h = (cc >> 6) & 3, e0 = cc & 63;
        dst = (bf16_t*)(ws + O_VAT) + ((size_t)((b * 3 + g) * 4 + h) * 64 + e0) * S; sh = 2 * g; return true;
    }
    if (c0 >= C_BKV && c0 < C_BG) {
        const int cc = c0 - C_BKV, i = cc >> 7, g = (cc >> 6) & 1, e0 = cc & 63;
        if (i == 3 || i == 5) { dst = (bf16_t*)(ws + O_CK + (size_t)i * 8 * MiB) + ((size_t)(b * 2 + g) * 64 + e0) * S; sh = 0; return true; }
    }
    return false;
}
struct EpiProj {
    static constexpr bool PERM = true, AFTER_DRAIN = false; static constexpr int MID_T = 0;
    unsigned char* ws_; unsigned char* lds_;
    __device__ __forceinline__ void operator()(const f32x4 (&acc)[2][2][4][2], const pg8::Unit& u, int wr, int wc, int fr, int fq) const {
        unsigned char* ws = ws_; asm volatile("" : "+s"(ws));
        const int lane = fq * 16 + fr;
        bf16_t* stg = (bf16_t*)(lds_ + (wr * 4 + wc) * 2048);
#pragma unroll
        for (int ai = 0; ai < 2; ++ai) {
            const int row0 = u.pm * 256 + ai * 128 + wr * 64;
            const int b = row0 >> 13, s0 = row0 & (S - 1);
#pragma unroll
            for (int bj = 0; bj < 2; ++bj) {
                const int cs = u.pn * 256 + bj * 128 + wc * 32;
                bf16_t* vdst = nullptr; int sh = 0;
                if (vspan(ws, cs, b, vdst, sh)) {
                    const int d = 1 << sh, per = 64 >> sh;
#pragma unroll
                    for (int ps = 0; ps < 2; ++ps) {
                        if ((fq >> 1) == ps) {
#pragma unroll
                            for (int m = 0; m < 4; ++m) {
                                const int t = 16 * m + fr, rho = (t & (d - 1)) * per + (t >> sh);
                                bf16_t* wp = stg + (8 * (fq & 1)) * 64 + rho;
                                const f32x4 v0 = acc[ai][bj][m][0], v1 = acc[ai][bj][m][1];
                                const unsigned w0 = pg8::cvt_pk_bf16(v0[0], v0[1]), w1 = pg8::cvt_pk_bf16(v0[2], v0[3]), w2 = pg8::cvt_pk_bf16(v1[0], v1[1]), w3 = pg8::cvt_pk_bf16(v1[2], v1[3]);
                                wp[0] = (bf16_t)(w0 & 0xffffu); wp[64] = (bf16_t)(w0 >> 16); wp[128] = (bf16_t)(w1 & 0xffffu); wp[192] = (bf16_t)(w1 >> 16);
                                wp[256] = (bf16_t)(w2 & 0xffffu); wp[320] = (bf16_t)(w2 >> 16); wp[384] = (bf16_t)(w3 & 0xffffu); wp[448] = (bf16_t)(w3 >> 16);
                            }
                        }
                        asm volatile("s_waitcnt lgkmcnt(0)" ::: "memory");
#pragma unroll
                        for (int k = 0; k < 2; ++k) {
                            const int col = lane >> 2, ch = (lane & 3) + 4 * k, pos = 8 * ch;
                            const v4u val = *(const v4u*)(stg + col * 64 + pos);
                            bf16_t* drow = vdst + (size_t)(16 * ps + col) * S;
                            if (sh < 4) {
                                const int rc = pos / per, li = pos - rc * per;
                                *(v4u*)(drow + (size_t)rc * (S >> sh) + (s0 >> sh) + li) = val;
                            } else {
                                const int rc = pos >> 2;
                                *(uint2*)(drow + (size_t)rc * (S >> 4) + (s0 >> 4)) = make_uint2(val.x, val.y);
                                *(uint2*)(drow + (size_t)(rc + 1) * (S >> 4) + (s0 >> 4)) = make_uint2(val.z, val.w);
                            }
                        }
                        asm volatile("s_waitcnt lgkmcnt(0)" ::: "memory");
                    }
                } else {
#pragma unroll
                    for (int m = 0; m < 4; ++m) { store_u8(ws, row0 + m * 16 + fr, cs + 8 * fq, acc[ai][bj][m][0], acc[ai][bj][m][1]); asm volatile("" ::: "memory"); }
                }
            }
        }
    }
};

struct EpiRowsBf16 {
    static constexpr bool PERM = true, AFTER_DRAIN = false; static constexpr int MID_T = 0;
    bf16_t* O; int ldc;
    __device__ __forceinline__ void operator()(const f32x4 (&acc)[2][2][4][2], const pg8::Unit& u, int wr, int wc, int fr, int fq) const {
#pragma unroll
        for (int ai = 0; ai < 2; ++ai)
#pragma unroll
            for (int m = 0; m < 4; ++m) {
                bf16_t* rowp = O + (size_t)(u.pm * 256 + ai * 128 + wr * 64 + m * 16 + fr) * ldc + u.pn * 256 + wc * 32 + 8 * fq;
#pragma unroll
                for (int bj = 0; bj < 2; ++bj) { const f32x4 a0 = acc[ai][bj][m][0], a1 = acc[ai][bj][m][1];
                    v4u w; w.x = pg8::cvt_pk_bf16(a0[0], a0[1]); w.y = pg8::cvt_pk_bf16(a0[2], a0[3]); w.z = pg8::cvt_pk_bf16(a1[0], a1[1]); w.w = pg8::cvt_pk_bf16(a1[2], a1[3]);
                    *(v4u*)(rowp + bj * 128) = w; }
                asm volatile("" ::: "memory");
            }
    }
};
struct EpiWout {
    static constexpr bool PERM = false, AFTER_DRAIN = false; static constexpr int MID_T = 0;
    const float* x; float* out;
    __device__ __forceinline__ void operator()(const f32x4 (&acc)[2][2][4][2], const pg8::Unit& u, int wr, int wc, int fr, int fq) const {
#pragma unroll
        for (int ai = 0; ai < 2; ++ai) {
            f32x4 xv[4][2][2];
#pragma unroll
            for (int m = 0; m < 4; ++m) {
                const size_t roff = (size_t)(u.pm * 256 + ai * 128 + wr * 64 + m * 16 + fr) * D + u.pn * 256 + wc * 32 + 4 * fq;
#pragma unroll
                for (int bj = 0; bj < 2; ++bj)
#pragma unroll
                    for (int n = 0; n < 2; ++n) xv[m][bj][n] = *(const f32x4*)(x + roff + bj * 128 + n * 16);
            }
            asm volatile("" ::: "memory");
#pragma unroll
            for (int m = 0; m < 4; ++m) {
                const size_t roff = (size_t)(u.pm * 256 + ai * 128 + wr * 64 + m * 16 + fr) * D + u.pn * 256 + wc * 32 + 4 * fq;
#pragma unroll
                for (int bj = 0; bj < 2; ++bj)
#pragma unroll
                    for (int n = 0; n < 2; ++n) *(f32x4*)(out + roff + bj * 128 + n * 16) = xv[m][bj][n] * ALPHA + acc[ai][bj][m][n];
            }
            asm volatile("" ::: "memory");
        }
    }
};
constexpr int CONV_EARLY = 0;
__device__ __forceinline__ void moe_weight_convert_range(const Params& p, unsigned char* ldsb, int lo, int hi, int wi, int nw);
__device__ __forceinline__ void ph_wout(const Params& p, unsigned char* ldsb) {
    const int bid = opq_bid(), gsz = opq_grid();
    pg8::Gemm g{1024, 1024, p.wbase};
    TileOrder Sd; Sd.init(p.ws + O_MERGED, p.ws + O_WOUTT, T, 1024, 1024, 1024, gsz, bid);
    EpiRowsBf16 E{(bf16_t*)(p.ws + O_H1B), 1024};
    pg8::gemm_phase<EpiRowsBf16, TileOrder, true, true>((PG8_LAS unsigned char*)ldsb, g, Sd, E);
}
__device__ __forceinline__ unsigned pk2(float lo, float hi) { return (unsigned)f2bf(lo) | ((unsigned)f2bf(hi) << 16); }
__device__ __forceinline__ void p0_transpose_item(const float* W, int K, int N, bf16_t* WT, int mode, LAS float* scr, int item, int lane, int ldo = 0) {
    if (ldo == 0) ldo = K;
    const int nblk = (N + 63) / 64, kb = item / nblk, nb = item % nblk, k0 = 64 * kb, n0 = 64 * nb;
    const int nl = n0 + lane; const bool ok = nl < N;
    const float* wp = W + (size_t)k0 * N + (ok ? nl : 0);
    float wv_[64];
#pragma unroll
    for (int i = 0; i < 64; ++i) wv_[i] = wp[(size_t)i * N];
#pragma unroll
    for (int i = 0; i < 64; ++i) scr[i * 65 + lane] = ok ? wv_[i] : 0.f;
    asm volatile("s_waitcnt lgkmcnt(0)" ::: "memory");
    const int c = lane & 7;
#pragma unroll
    for (int j = 0; j < 8; ++j) {
        const int n = (lane >> 3) + 8 * j; const LAS float* sp = scr + (8 * c) * 65 + n;
        v4u o; o.x = pk2(sp[0 * 65], sp[1 * 65]); o.y = pk2(sp[2 * 65], sp[3 * 65]); o.z = pk2(sp[4 * 65], sp[5 * 65]); o.w = pk2(sp[6 * 65], sp[7 * 65]);
        const int nn = n0 + n;
        const int row = mode ? ((nn < 512) ? ((nn >> 7) * 256 + (nn & 127)) : ((((nn - 512) >> 7) * 256) + 128 + ((nn - 512) & 127))) : nn;
        *(v4u*)(WT + (size_t)row * ldo + k0 + 8 * c) = o;
    }
    asm volatile("s_waitcnt lgkmcnt(0)" ::: "memory");
}
__device__ __forceinline__ void ph_prologue(const Params& p, unsigned char* ldsb) {
    const int tid = opq_tid(p.wbase), bid = opq_bid(), gsz = opq_grid(); const int lane = tid & 63, wv = tid >> 6;
    LAS float* scr = (LAS float*)(LAS unsigned char*)ldsb + wv * (64 * 65);
    const int gw = bid * NWAVES + wv, NGW = gsz * NWAVES;
    unsigned char* ws = p.ws;
    constexpr int I_IN = 16 * 89;
    for (int it = gw; it < I_IN; it += NGW) p0_transpose_item(p.w_in, 1024, INC, (bf16_t*)(ws + O_WINT), 0, scr, it, lane);
    bf16_t* XB = (bf16_t*)(ws + O_XB);
    for (int m = gw; m < T; m += 2 * NGW) {
        const f32x4* xr = (const f32x4*)(p.x + (size_t)m * D) + lane; const f32x4* xr2 = (const f32x4*)(p.x + (size_t)(m + NGW) * D) + lane;
        unsigned long long* o8 = (unsigned long long*)(XB + (size_t)m * D) + lane; unsigned long long* o82 = (unsigned long long*)(XB + (size_t)(m + NGW) * D) + lane;
        f32x4 v[8];
#pragma unroll
        for (int j = 0; j < 4; ++j) { v[j] = xr[64 * j]; v[4 + j] = xr2[64 * j]; }
#pragma unroll
        for (int j = 0; j < 4; ++j) { o8[64 * j] = (unsigned long long)pg8::cvt_pk_bf16(v[j][0], v[j][1]) | ((unsigned long long)pg8::cvt_pk_bf16(v[j][2], v[j][3]) << 32);
                                      o82[64 * j] = (unsigned long long)pg8::cvt_pk_bf16(v[4 + j][0], v[4 + j][1]) | ((unsigned long long)pg8::cvt_pk_bf16(v[4 + j][2], v[4 + j][3]) << 32); }
    }
}
__device__ __forceinline__ void prologue_deferred(const Params& p, unsigned char* ldsb, int wi, int nw);
__device__ __forceinline__ void ph_proj(const Params& p, unsigned char* ldsb) {
    const int bid = opq_bid(), gsz = opq_grid();
    pg8::Gemm g{1024, 1024, p.wbase};
    TileOrder Sd; Sd.init(p.ws + O_XB, p.ws + O_WINT, T, NPAD_IN, 1024, 1024, gsz, bid);
    EpiProj E{p.ws, ldsb + 131072};
    pg8::gemm_phase<EpiProj, TileOrder, true, true>((PG8_LAS unsigned char*)ldsb, g, Sd, E);
    const int nwg = (T / 256) * (NPAD_IN / 256), rounds = (nwg + gsz - 1) / gsz, nbusy = nwg - (rounds - 1) * gsz, nidle = gsz - nbusy;
    const int wv = __builtin_amdgcn_readfirstlane(opq_tid(p.wbase) >> 6);
    __syncthreads();
    if (nidle * 4 >= gsz) { if (bid >= nbusy) prologue_deferred(p, ldsb, (bid - nbusy) * NWAVES + wv, nidle * NWAVES); }
    else prologue_deferred(p, ldsb, bid * NWAVES + wv, gsz * NWAVES);
}


struct EpiMerge1 {
    static constexpr bool PERM = true, AFTER_DRAIN = false; static constexpr int MID_T = 4;
    unsigned char* ws;
    __device__ __forceinline__ void mid(f32x4 (&acc)[2][2][4][2], const pg8::Unit& u, int wr, int wc, int fr, int fq) const {
        const bf16_t* MG = (const bf16_t*)(ws + O_MG);
#pragma unroll
        for (int ai = 0; ai < 2; ++ai) {
            v4u gav[4][2], gbv[4][2];
#pragma unroll
            for (int m = 0; m < 4; ++m) {
                const int row = u.pm * 256 + ai * 128 + wr * 64 + m * 16 + fr;
#pragma unroll
                for (int bj = 0; bj < 2; ++bj) {
                    const int c0 = u.pn * 256 + bj * 128 + wc * 32 + 8 * fq;
                    gav[m][bj] = *(const v4u*)(MG + (size_t)row * 2048 + c0); gbv[m][bj] = *(const v4u*)(MG + (size_t)row * 2048 + 1024 + c0);
                }
            }
            asm volatile("" ::: "memory");
#pragma unroll
            for (int m = 0; m < 4; ++m) {
#pragma unroll
                for (int bj = 0; bj < 2; ++bj) {
                    const v4u ga = gav[m][bj], gb = gbv[m][bj];
                    float ra[8], rb[8];
                    ra[0] = __uint_as_float(ga.x << 16); ra[1] = __uint_as_float(ga.x & 0xffff0000u); ra[2] = __uint_as_float(ga.y << 16); ra[3] = __uint_as_float(ga.y & 0xffff0000u);
                    ra[4] = __uint_as_float(ga.z << 16); ra[5] = __uint_as_float(ga.z & 0xffff0000u); ra[6] = __uint_as_float(ga.w << 16); ra[7] = __uint_as_float(ga.w & 0xffff0000u);
                    rb[0] = __uint_as_float(gb.x << 16); rb[1] = __uint_as_float(gb.x & 0xffff0000u); rb[2] = __uint_as_float(gb.y << 16); rb[3] = __uint_as_float(gb.y & 0xffff0000u);
                    rb[4] = __uint_as_float(gb.z << 16); rb[5] = __uint_as_float(gb.z & 0xffff0000u); rb[6] = __uint_as_float(gb.w << 16); rb[7] = __uint_as_float(gb.w & 0xffff0000u);
#pragma unroll
                    for (int j = 0; j < 4; ++j) {
                        acc[ai][bj][m][0][j] *= ra[j] * __builtin_amdgcn_rcpf(fmaxf(rb[j], 9.094947e-13f));
                        acc[ai][bj][m][1][j] *= ra[4 + j] * __builtin_amdgcn_rcpf(fmaxf(rb[4 + j], 9.094947e-13f));
                    }
                }
            }
            asm volatile("" ::: "memory");
        }
    }
    __device__ __forceinline__ void operator()(const f32x4 (&acc)[2][2][4][2], const pg8::Unit& u, int wr, int wc, int fr, int fq) const {
        const bf16_t* MG = (const bf16_t*)(ws + O_MG); bf16_t* MERGED = (bf16_t*)(ws + O_MERGED);
#pragma unroll
        for (int ai = 0; ai < 2; ++ai) {
            v4u gvv[4][2];
#pragma unroll
            for (int m = 0; m < 4; ++m)
#pragma unroll
                for (int bj = 0; bj < 2; ++bj) gvv[m][bj] = *(const v4u*)(MG + (size_t)(u.pm * 256 + ai * 128 + wr * 64 + m * 16 + fr) * 2048 + 1024 + u.pn * 256 + bj * 128 + wc * 32 + 8 * fq);
            asm volatile("" ::: "memory");
#pragma unroll
            for (int m = 0; m < 4; ++m) {
                const int row = u.pm * 256 + ai * 128 + wr * 64 + m * 16 + fr;
#pragma unroll
                for (int bj = 0; bj < 2; ++bj) {
                    const int c0 = u.pn * 256 + bj * 128 + wc * 32 + 8 * fq;
                    const v4u gv = gvv[m][bj];
                    const f32x4 a0 = acc[ai][bj][m][0], a1 = acc[ai][bj][m][1];
                    float r[8];
                    r[0] = fmaxf(__uint_as_float(gv.x << 16), 9.094947e-13f) * a0[0]; r[1] = fmaxf(__uint_as_float(gv.x & 0xffff0000u), 9.094947e-13f) * a0[1];
                    r[2] = fmaxf(__uint_as_float(gv.y << 16), 9.094947e-13f) * a0[2]; r[3] = fmaxf(__uint_as_float(gv.y & 0xffff0000u), 9.094947e-13f) * a0[3];
                    r[4] = fmaxf(__uint_as_float(gv.z << 16), 9.094947e-13f) * a1[0]; r[5] = fmaxf(__uint_as_float(gv.z & 0xffff0000u), 9.094947e-13f) * a1[1];
                    r[6] = fmaxf(__uint_as_float(gv.w << 16), 9.094947e-13f) * a1[2]; r[7] = fmaxf(__uint_as_float(gv.w & 0xffff0000u), 9.094947e-13f) * a1[3];
                    v4u w; w.x = pg8::cvt_pk_bf16(r[0], r[1]); w.y = pg8::cvt_pk_bf16(r[2], r[3]); w.z = pg8::cvt_pk_bf16(r[4], r[5]); w.w = pg8::cvt_pk_bf16(r[6], r[7]);
                    *(v4u*)(MERGED + (size_t)row * D + c0) = w;
                }
            }
            asm volatile("" ::: "memory");
        }
    }
};
__device__ __forceinline__ void ph_merge(const Params& p, unsigned char* ldsb) {
    const int bid = opq_bid(), gsz = opq_grid();
    unsigned char* ws = p.ws; asm volatile("" : "+s"(ws));
    pg8::Gemm g{768, 768, p.wbase}; TileOrder Sd; Sd.init(ws + O_YAB, ws + O_WBAT, T, 1024, 768, 768, gsz, bid); EpiMerge1 E{ws};
    pg8::gemm_phase<EpiMerge1, TileOrder, true, true>((PG8_LAS unsigned char*)ldsb, g, Sd, E);
}

constexpr int LDS_TAB = 131072;
__device__ __forceinline__ void moe_tables(const Params& p, unsigned char* ldsb, int ncol, int tid) {
    int* tab = (int*)(ldsb + LDS_TAB);
    if (tid < 64) {
        const int* CNT = (const int*)(p.ws + O_CNT);
        const int cnt = tid < NEXP ? CNT[tid] : 0, nrb = (cnt + 255) >> 8;
        int incl = nrb;
#pragma unroll
        for (int o = 1; o < 32; o <<= 1) { const int v = __shfl_up(incl, o); if (tid >= o) incl += v; }
        const int excl = incl - nrb;
        if (tid < NEXP) { tab[tid] = excl * ncol; tab[40 + tid] = excl * 256; tab[80 + tid] = cnt; }
        if (tid == NEXP - 1) { tab[NEXP] = incl * ncol; tab[40 + NEXP] = incl * 256; }
    }
    __syncthreads();
}
struct MoeOrder {
    const int* tab; int G, c, ncol; const char* A; const char* Bt; size_t arow, bexp, btile; const int* list;
    __device__ __forceinline__ bool next(int i, pg8::Unit& u) const {
        const int nwg = tab[NEXP];
        const int L0 = i * G + c; if (L0 >= nwg) return false;
        int L = L0; { const int q = nwg / 8, r = nwg % 8, xcd = L0 % 8, off = L0 / 8; L = (xcd < r ? xcd * (q + 1) : r * (q + 1) + (xcd - r) * q) + off; }
        const int ln_ = (int)__builtin_amdgcn_mbcnt_hi(~0u, __builtin_amdgcn_mbcnt_lo(~0u, 0u));
        const int tv_ = tab[ln_ < NEXP ? ln_ : 0];
        const int e = __builtin_amdgcn_readfirstlane(__popcll(__ballot(ln_ < NEXP && tv_ <= L)) - 1);
        const int rem = L - tab[e], rb = rem / ncol, pn = rem - rb * ncol;
        u.pm = (tab[40 + e] >> 8) + rb; u.pn = pn; u.b = Bt + (size_t)e * bexp + (size_t)pn * btile;
        if (list) { u.a = A; u.rows = list + (size_t)e * T + rb * 256; u.nrows = tab[80 + e] - rb * 256; } else { u.a = A + (size_t)u.pm * 256 * arow; u.rows = nullptr; u.nrows = 0; }
        return true;
    }
    __device__ __forceinline__ void a_ready(const pg8::Unit&) const {}
    __device__ __forceinline__ void done(const pg8::Unit&) const {}
};
__device__ __forceinline__ void ph_moe_gather(const Params& p, unsigned char* ldsb) {
    const int tid = opq_tid(p.wbase), bid = opq_bid(), gsz = opq_grid(); const int lane = tid & 63, wv = tid >> 6;
    moe_tables(p, ldsb, 4, tid);
    const int* tab = (const int*)(ldsb + LDS_TAB);
    const int* CNT = (const int*)(p.ws + O_CNT); const int* LIST = (const int*)(p.ws + O_LIST);
    const bf16_t* H1B = (const bf16_t*)(p.ws + O_H1B); bf16_t* XG = (bf16_t*)(p.ws + O_XG);
    const int P = tab[40 + NEXP];
    for (int r = bid * NWAVES + wv; r < P; r += gsz * NWAVES) {
        int e = 0;
#pragma unroll 1
        for (int k = 1; k < NEXP; ++k) if (tab[40 + k] <= r) e = k;
        const int slot = r - tab[40 + e];
        v4u v0 = {0u, 0u, 0u, 0u}, v1 = {0u, 0u, 0u, 0u};
        if (slot < CNT[e]) { const int tok = LIST[(size_t)e * T + slot] >> 1; const v4u* src = (const v4u*)(H1B + (size_t)tok * D); v0 = src[lane]; v1 = src[64 + lane]; }
        v4u* dst = (v4u*)(XG + (size_t)r * D); dst[lane] = v0; dst[64 + lane] = v1;
    }
}
struct EpiSwiGLU {
    static constexpr bool PERM = true, AFTER_DRAIN = false; static constexpr int MID_T = 0;
    bf16_t* ACT;
    __device__ __forceinline__ void operator()(const f32x4 (&acc)[2][2][4][2], const pg8::Unit& u, int wr, int wc, int fr, int fq) const {
#pragma unroll
        for (int ai = 0; ai < 2; ++ai)
#pragma unroll
            for (int m = 0; m < 4; ++m) {
                const int row = u.pm * 256 + ai * 128 + wr * 64 + m * 16 + fr;
                float r[8];
#pragma unroll
                for (int n = 0; n < 2; ++n)
#pragma unroll
                    for (int j = 0; j < 4; ++j) { const float gv = acc[ai][0][m][n][j]; r[n * 4 + j] = gv * __builtin_amdgcn_rcpf(1.f + __expf(-gv)) * acc[ai][1][m][n][j]; }
                v4u w; w.x = pg8::cvt_pk_bf16(r[0], r[1]); w.y = pg8::cvt_pk_bf16(r[2], r[3]); w.z = pg8::cvt_pk_bf16(r[4], r[5]); w.w = pg8::cvt_pk_bf16(r[6], r[7]);
                *(v4u*)(ACT + (size_t)row * DEXP + u.pn * 128 + wc * 32 + 8 * fq) = w;
                asm volatile("" ::: "memory");
            }
    }
};
__device__ __forceinline__ void ph_moe_up(const Params& p, unsigned char* ldsb) {
    const int tid = opq_tid(p.wbase), bid = opq_bid(), gsz = opq_grid();
    moe_tables(p, ldsb, 4, tid);
    pg8::Gemm g{1024, 1024, p.wbase};
    MoeOrder Sd{(const int*)(ldsb + LDS_TAB), gsz, bid, 4, (const char*)(p.ws + O_H1B), (const char*)(p.ws + O_WGUT), (size_t)1024 * 2, (size_t)1024 * 1024 * 2, (size_t)256 * 1024 * 2, (const int*)(p.ws + O_LIST)};
    EpiSwiGLU E{(bf16_t*)(p.ws + O_ACT)};
    pg8::gemm_phase<EpiSwiGLU, MoeOrder, true, true, true>((PG8_LAS unsigned char*)ldsb, g, Sd, E);
}
__device__ __forceinline__ void ph_moe_down(const Params& p, unsigned char* ldsb) {
    const int tid = opq_tid(p.wbase), bid = opq_bid(), gsz = opq_grid();
    moe_tables(p, ldsb, 4, tid);
    pg8::Gemm g{512, 512, p.wbase};
    MoeOrder Sd{(const int*)(ldsb + LDS_TAB), gsz, bid, 4, (const char*)(p.ws + O_ACT), (const char*)(p.ws + O_WDT), (size_t)512 * 2, (size_t)1024 * 512 * 2, (size_t)256 * 512 * 2, nullptr};
    EpiRowsBf16 E{(bf16_t*)(p.ws + O_YE), 1024};
    pg8::gemm_phase<EpiRowsBf16, MoeOrder, true, true>((PG8_LAS unsigned char*)ldsb, g, Sd, E);
}
__device__ __forceinline__ void moe_weight_convert_range(const Params& p, unsigned char* ldsb, int lo, int hi, int wi, int nw) {
    const int tid = opq_tid(p.wbase); const int lane = tid & 63, wv = tid >> 6;
    LAS float* scr = (LAS float*)(LAS unsigned char*)ldsb + wv * (64 * 65);
    constexpr int I_GU = 16 * 16, I_D = 8 * 16;
    for (int it = lo + wi; it < hi; it += nw) {
        if (it < NEXP * I_GU) { const int e = it / I_GU; p0_transpose_item(p.w_gate_up + (size_t)e * 1024 * 1024, 1024, 1024, (bf16_t*)(p.ws + O_WGUT) + (size_t)e * 1024 * 1024, 1, scr, it % I_GU, lane); }
        else { const int r = it - NEXP * I_GU, e = r / I_D; p0_transpose_item(p.w_down + (size_t)e * 512 * 1024, 512, 1024, (bf16_t*)(p.ws + O_WDT) + (size_t)e * 1024 * 512, 0, scr, r % I_D, lane); }
    }
}
__device__ __forceinline__ void ph_final2(const Params& p) {
    const int tid = opq_tid(p.wbase), bid = opq_bid(), gsz = opq_grid(); const int lane = tid & 63, wv = tid >> 6;
    const bf16_t* YE = (const bf16_t*)(p.ws + O_YE); const float* WTS = (const float*)(p.ws + O_WTS); const int* ES = (const int*)(p.ws + O_ES); const int* CNT = (const int*)(p.ws + O_CNT);
    const bf16_t* H1B = (const bf16_t*)(p.ws + O_H1B);
    int pst = 0;
    { const int pc = lane < NEXP ? (((CNT[lane] + 255) >> 8) << 8) : 0; int incl = pc;
#pragma unroll
      for (int o = 1; o < 32; o <<= 1) { const int v = __shfl_up(incl, o); if (lane >= o) incl += v; }
      pst = incl - pc; }
    const int NGW = gsz * NWAVES;
    const bool pref = T <= 64 * NGW;
    float pw0 = 0.f, pw1 = 0.f; int pe0 = 0, pe1 = 0;
    { const int tj = bid * NWAVES + wv + lane * NGW; if (pref && tj < T) { pw0 = WTS[2 * tj]; pw1 = WTS[2 * tj + 1]; pe0 = ES[2 * tj]; pe1 = ES[2 * tj + 1]; } }
    float4 gg4[4], bb4[4];
#pragma unroll
    for (int j = 0; j < 4; ++j) { gg4[j] = *(const float4*)(p.ln2_g + j * 256 + lane * 4); bb4[j] = *(const float4*)(p.ln2_b + j * 256 + lane * 4); }
    int it_ = 0;
    for (int t0_ = bid * NWAVES + wv; t0_ < T; t0_ += 2 * NGW, ++it_) {
        float v[2][16];
#pragma unroll
        for (int u = 0; u < 2; ++u) {
            const int t = t0_ + u * NGW;
            const bf16_t* row = H1B + (size_t)t * D;
            const int jj = 2 * it_ + u;
            const float w0 = pref ? __shfl(pw0, jj) : WTS[2 * t], w1 = pref ? __shfl(pw1, jj) : WTS[2 * t + 1];
            const int es0 = pref ? __shfl(pe0, jj) : ES[2 * t], es1 = pref ? __shfl(pe1, jj) : ES[2 * t + 1];
            const size_t pos0 = (size_t)(__shfl(pst, es0 >> 16) + (es0 & 0xffff)), pos1 = (size_t)(__shfl(pst, es1 >> 16) + (es1 & 0xffff));
#pragma unroll
            for (int j = 0; j < 4; ++j) {
                const ushort4 fb = *(const ushort4*)(row + j * 256 + lane * 4); const float4 f = make_float4(bf2f(fb.x), bf2f(fb.y), bf2f(fb.z), bf2f(fb.w));
                const ushort4 a = *(const ushort4*)(YE + pos0 * D + j * 256 + lane * 4), bq = *(const ushort4*)(YE + pos1 * D + j * 256 + lane * 4);
                v[u][j * 4] = ALPHA * f.x + w0 * bf2f(a.x) + w1 * bf2f(bq.x); v[u][j * 4 + 1] = ALPHA * f.y + w0 * bf2f(a.y) + w1 * bf2f(bq.y);
                v[u][j * 4 + 2] = ALPHA * f.z + w0 * bf2f(a.z) + w1 * bf2f(bq.z); v[u][j * 4 + 3] = ALPHA * f.w + w0 * bf2f(a.w) + w1 * bf2f(bq.w);
            }
        }
        float mu[2], rstd[2];
#pragma unroll
        for (int u = 0; u < 2; ++u) { float sm = 0.f;
#pragma unroll
            for (int j = 0; j < 16; ++j) sm += v[u][j];
            mu[u] = sm; }
        mu[0] = wave_sum(mu[0]) * (1.f / D); mu[1] = wave_sum(mu[1]) * (1.f / D);
#pragma unroll
        for (int u = 0; u < 2; ++u) { float sq = 0.f;
#pragma unroll
            for (int j = 0; j < 16; ++j) { v[u][j] -= mu[u]; sq += v[u][j] * v[u][j]; }
            rstd[u] = sq; }
        rstd[0] = rsqrtf(wave_sum(rstd[0]) * (1.f / D) + LN_EPS); rstd[1] = rsqrtf(wave_sum(rstd[1]) * (1.f / D) + LN_EPS);
#pragma unroll
        for (int u = 0; u < 2; ++u) {
            float* row = p.out + (size_t)(t0_ + u * NGW) * D;
#pragma unroll
            for (int j = 0; j < 4; ++j) {
                const float4 gg = gg4[j], bb = bb4[j];
                *(float4*)(row + j * 256 + lane * 4) = make_float4(v[u][j * 4] * rstd[u] * gg.x + bb.x, v[u][j * 4 + 1] * rstd[u] * gg.y + bb.y, v[u][j * 4 + 2] * rstd[u] * gg.z + bb.z, v[u][j * 4 + 3] * rstd[u] * gg.w + bb.w);
            }
        }
    }
}

typedef short bf16x8 __attribute__((ext_vector_type(8)));
#define MFMA16(a, b, c) __builtin_amdgcn_mfma_f32_16x16x32_bf16((a), (b), (c), 0, 0, 0)
constexpr float LOG2E = 1.4426950408889634f, LN2 = 0.6931471805599453f;
constexpr float QK_C = 1.0f;
__device__ __forceinline__ bf16x8 pack_p(const f32x4 p0, const f32x4 p1) {
    v4u w; w.x = pg8::cvt_pk_bf16(p0[0], p0[1]); w.y = pg8::cvt_pk_bf16(p0[2], p0[3]); w.z = pg8::cvt_pk_bf16(p1[0], p1[1]); w.w = pg8::cvt_pk_bf16(p1[2], p1[3]);
    return __builtin_bit_cast(bf16x8, w);
}
__device__ __forceinline__ void load_kf(bf16x8 (&kf)[2][2], const bf16_t* Kp, int i, int h) {
    const bf16_t* r0 = Kp + (size_t)(8 * (i >> 2) + (i & 3)) * 64 + 8 * h;
    kf[0][0] = *(const bf16x8*)(r0); kf[0][1] = *(const bf16x8*)(r0 + 32);
    kf[1][0] = *(const bf16x8*)(r0 + 4 * 64); kf[1][1] = *(const bf16x8*)(r0 + 4 * 64 + 32);
}
__device__ __forceinline__ void load_vf(bf16x8 (&vf)[4], const bf16_t* VTp, size_t vstride, int i, int h) {
#pragma unroll
    for (int dt = 0; dt < 4; ++dt) vf[dt] = *(const bf16x8*)(VTp + (size_t)(16 * dt + i) * vstride + 8 * h);
}
__device__ __forceinline__ float hmax4(float v) {
    auto a = __builtin_amdgcn_permlane16_swap(__float_as_uint(v), __float_as_uint(v), false, false);
    v = fmaxf(__uint_as_float(a[0]), __uint_as_float(a[1]));
    auto b = __builtin_amdgcn_permlane32_swap(__float_as_uint(v), __float_as_uint(v), false, false);
    return fmaxf(__uint_as_float(b[0]), __uint_as_float(b[1]));
}
__device__ __forceinline__ float hsum4(float v) {
    auto a = __builtin_amdgcn_permlane16_swap(__float_as_uint(v), __float_as_uint(v), false, false);
    v = __uint_as_float(a[0]) + __uint_as_float(a[1]);
    auto b = __builtin_amdgcn_permlane32_swap(__float_as_uint(v), __float_as_uint(v), false, false);
    return __uint_as_float(b[0]) + __uint_as_float(b[1]);
}
__device__ __forceinline__ int isum_h4(int v) {
    auto a = __builtin_amdgcn_permlane16_swap((unsigned)v, (unsigned)v, false, false);
    v = (int)(a[0] + a[1]);
    auto b = __builtin_amdgcn_permlane32_swap((unsigned)v, (unsigned)v, false, false);
    return (int)(b[0] + b[1]);
}
__device__ __forceinline__ void softmax_step(f32x4& x0, f32x4& x1, unsigned vm0, unsigned vm1, float& m, float& l, f32x4 (&o)[4]) {
    float tm = fmaxf(fmaxf(fmaxf(x0[0], x0[1]), fmaxf(x0[2], x0[3])), fmaxf(fmaxf(x1[0], x1[1]), fmaxf(x1[2], x1[3])));
    tm = hmax4(tm);
    const float mn = fmaxf(m, tm);
    const float alpha = __builtin_amdgcn_exp2f(m - mn);
    m = mn;
    float sum = 0.f;
#pragma unroll
    for (int r = 0; r < 4; ++r) {
        x0[r] = (vm0 >> r) & 1u ? __builtin_amdgcn_exp2f(x0[r] - mn) : 0.f;
        x1[r] = (vm1 >> r) & 1u ? __builtin_amdgcn_exp2f(x1[r] - mn) : 0.f;
        sum += x0[r] + x1[r];
    }
    l = l * alpha + sum;
#pragma unroll
    for (int dt = 0; dt < 4; ++dt) o[dt] = o[dt] * alpha;
}

__device__ __forceinline__ void ph_dilated(const Params& p) {
    const int tid = opq_tid(p.wbase), bid = opq_bid(), gsz = opq_grid(); const int lane = tid & 63, wv = tid >> 6, i = lane & 15, h = lane >> 4;
    const bf16_t* QA = (const bf16_t*)(p.ws + O_QA); const bf16_t* KA = (const bf16_t*)(p.ws + O_KA); const bf16_t* VAT = (const bf16_t*)(p.ws + O_VAT);
    bf16_t* OG = (bf16_t*)(p.ws + O_OG); float* LSE = (float*)(p.ws + O_LSE);
    int* ctr = (int*)(p.ws + O_CNT) + 66;
    for (;;) {
        int task0 = 0; if (lane == 0) task0 = atomicAdd(ctr, 4); task0 = __builtin_amdgcn_readfirstlane(task0);
        if (task0 >= NB * 12 * (S / 32)) break;
#pragma unroll 1
        for (int task = task0; task < task0 + 4; ++task) {
        const int qb = task & 255, bgh = task >> 8, hd = bgh & 3, g = (bgh >> 2) % 3, b = bgh / 12;
        const int sh = 2 * g, d = 1 << sh, L = S >> sh, P0 = qb * 32, r = P0 / L, l0 = P0 - r * L;
        const float slope2 = exp2f(-8.0f * (float)(g * 4 + hd + 1) / 12.0f) * LOG2E * (float)d;
        const size_t base = (size_t)bgh;
        const bf16_t* Qp = QA + (base * S + P0) * 64;
        bf16x8 qf[2][2];
#pragma unroll
        for (int qt = 0; qt < 2; ++qt) { qf[qt][0] = *(const bf16x8*)(Qp + (size_t)(qt * 16 + i) * 64 + 8 * h); qf[qt][1] = *(const bf16x8*)(Qp + (size_t)(qt * 16 + i) * 64 + 8 * h + 32); }
        float m[2] = {-1e30f, -1e30f}, l[2] = {0.f, 0.f};
        f32x4 o[2][4];
#pragma unroll
        for (int qt = 0; qt < 2; ++qt)
#pragma unroll
            for (int dt = 0; dt < 4; ++dt) o[qt][dt] = (f32x4){0.f, 0.f, 0.f, 0.f};
#pragma unroll 1
        for (int kt = 0; kt < 5; ++kt) {
            const int key0 = l0 - 128 + 32 * kt;
            if (key0 < 0) continue;
            bf16x8 kf[2][2], vf[4];
            load_kf(kf, KA + (base * S + (size_t)r * L + key0) * 64, i, h);
            load_vf(vf, VAT + (base * 64) * S + (size_t)r * L + key0, S, i, h);
#pragma unroll
            for (int qt = 0; qt < 2; ++qt) {
                f32x4 x0 = MFMA16(kf[0][0], qf[qt][0], ((f32x4){0.f, 0.f, 0.f, 0.f})); x0 = MFMA16(kf[0][1], qf[qt][1], x0);
                f32x4 x1 = MFMA16(kf[1][0], qf[qt][0], ((f32x4){0.f, 0.f, 0.f, 0.f})); x1 = MFMA16(kf[1][1], qf[qt][1], x1);
                const int dq = (l0 + qt * 16 + i) - (key0 + 8 * h);
                unsigned vm0 = 0u, vm1 = 0u;
#pragma unroll
                for (int rr = 0; rr < 4; ++rr) {
                    const int d0 = dq - rr, d1 = dq - 4 - rr;
                    const bool ok0 = d0 >= 0 && d0 <= 128, ok1 = d1 >= 0 && d1 <= 128;
                    x0[rr] = ok0 ? x0[rr] * QK_C - slope2 * (float)d0 : -1e30f; x1[rr] = ok1 ? x1[rr] * QK_C - slope2 * (float)d1 : -1e30f;
                    vm0 |= ok0 ? (1u << rr) : 0u; vm1 |= ok1 ? (1u << rr) : 0u;
                }
                softmax_step(x0, x1, vm0, vm1, m[qt], l[qt], o[qt]);
                const bf16x8 pf = pack_p(x0, x1);
#pragma unroll
                for (int dt = 0; dt < 4; ++dt) o[qt][dt] = MFMA16(vf[dt], pf, o[qt][dt]);
            }
        }
#pragma unroll
        for (int qt = 0; qt < 2; ++qt) {
            float lt = l[qt]; lt = hsum4(lt);
            const float inv = 1.f / lt;
            const int sp = (l0 + qt * 16 + i) * d + r;
            const size_t t = (size_t)b * S + sp;
            bf16_t* op = OG + (t * 3 + g) * 256 + hd * 64 + 4 * h;
#pragma unroll
            for (int dt = 0; dt < 4; ++dt) {
                const f32x4 v = o[qt][dt] * inv;
                uint2 w; w.x = pg8::cvt_pk_bf16(v[0], v[1]); w.y = pg8::cvt_pk_bf16(v[2], v[3]);
                *(uint2*)(op + 16 * dt) = w;
            }
            if (h == 0) LSE[t * 12 + g * 4 + hd] = (m[qt] + log2f(lt)) * LN2;
        }
        }
    }
}
__device__ __forceinline__ void ph_combine(const Params& p) {
    const int tid = opq_tid(p.wbase), bid = opq_bid(), gsz = opq_grid(); const int lane = tid & 63, wv = tid >> 6;
    const bf16_t* OG = (const bf16_t*)(p.ws + O_OG); const float* LSE = (const float*)(p.ws + O_LSE); bf16_t* YA = (bf16_t*)(p.ws + O_YAB);
    const int hd = lane >> 4;
    const int NGW = gsz * NWAVES;
    for (int tb_ = bid * NWAVES + wv; tb_ < T; tb_ += 4 * NGW) {
        float ls[4][3]; uint2 og[4][3];
#pragma unroll
        for (int u = 0; u < 4; ++u) {
            const int t = tb_ + u * NGW < T ? tb_ + u * NGW : tb_;
#pragma unroll
            for (int k = 0; k < 3; ++k) { ls[u][k] = LSE[(size_t)t * 12 + 4 * k + hd]; og[u][k] = *(const uint2*)(OG + ((size_t)t * 3 + k) * 256 + lane * 4); }
        }
#pragma unroll
        for (int u = 0; u < 4; ++u) {
            const int t = tb_ + u * NGW;
            if (t < T) {
                const float l0 = ls[u][0], l1 = ls[u][1], l2 = ls[u][2];
                const float mx = fmaxf(l0, fmaxf(l1, l2));
                float w0 = expf(l0 - mx), w1 = expf(l1 - mx), w2 = expf(l2 - mx);
                const float inv = 1.f / (w0 + w1 + w2); w0 *= inv; w1 *= inv; w2 *= inv;
                const uint2 a = og[u][0], bb = og[u][1], c = og[u][2];
                const float r0 = w0 * __uint_as_float(a.x << 16) + w1 * __uint_as_float(bb.x << 16) + w2 * __uint_as_float(c.x << 16);
                const float r1 = w0 * __uint_as_float(a.x & 0xffff0000u) + w1 * __uint_as_float(bb.x & 0xffff0000u) + w2 * __uint_as_float(c.x & 0xffff0000u);
                const float r2 = w0 * __uint_as_float(a.y << 16) + w1 * __uint_as_float(bb.y << 16) + w2 * __uint_as_float(c.y << 16);
                const float r3 = w0 * __uint_as_float(a.y & 0xffff0000u) + w1 * __uint_as_float(bb.y & 0xffff0000u) + w2 * __uint_as_float(c.y & 0xffff0000u);
                uint2 w; w.x = pg8::cvt_pk_bf16(r0, r1); w.y = pg8::cvt_pk_bf16(r2, r3);
                *(uint2*)(YA + (size_t)t * 768 + lane * 4) = w;
            }
        }
    }
}

__device__ __forceinline__ void ml_step(const f32x4 x0, const f32x4 x1, unsigned vm0, unsigned vm1, float& m, float& l) {
    float tm = fmaxf(fmaxf(fmaxf(x0[0], x0[1]), fmaxf(x0[2], x0[3])), fmaxf(fmaxf(x1[0], x1[1]), fmaxf(x1[2], x1[3])));
    tm = hmax4(tm);
    const float mn = fmaxf(m, tm);
    float sum = 0.f;
#pragma unroll
    for (int r = 0; r < 4; ++r) { sum += ((vm0 >> r) & 1u) ? __builtin_amdgcn_exp2f(x0[r] - mn) : 0.f; sum += ((vm1 >> r) & 1u) ? __builtin_amdgcn_exp2f(x1[r] - mn) : 0.f; }
    l = l * __builtin_amdgcn_exp2f(m - mn) + sum; m = mn;
}

struct CmpOrder {
    int G, c; const char* A0; const char* A1; const char* B0; const char* B1; size_t tstepA;
    __device__ __forceinline__ bool next(int i, pg8::Unit& u) const {
        const int L = i * G + c; if (L >= 32) return false;
        const int kv = L >> 4, rt = L & 15;
        u.pm = kv * 16 + rt; u.pn = 0; u.a = (kv ? A1 : A0) + (size_t)rt * tstepA; u.b = kv ? B1 : B0; u.rows = nullptr; u.nrows = 0; return true;
    }
    __device__ __forceinline__ void a_ready(const pg8::Unit&) const {}
    __device__ __forceinline__ void done(const pg8::Unit&) const {}
};
__device__ __forceinline__ float gelu_tanh_fast(float v) {
    const float u = 0.7978845608028654f * (v + 0.044715f * v * v * v);
    const float e = __expf(2.f * u);
    return 0.5f * v * (2.f - 2.f * __builtin_amdgcn_rcpf(e + 1.f));
}
struct EpiCmp1 {
    static constexpr bool PERM = true, AFTER_DRAIN = false; static constexpr int MID_T = 0;
    bf16_t* HID; const float* CB;
    __device__ __forceinline__ void operator()(const f32x4 (&acc)[2][2][4][2], const pg8::Unit& u, int wr, int wc, int fr, int fq) const {
        const float* bias = CB + (u.pm >> 4) * 256;
#pragma unroll
        for (int ai = 0; ai < 2; ++ai)
#pragma unroll
            for (int m = 0; m < 4; ++m) {
                bf16_t* rowp = HID + (size_t)(u.pm * 256 + ai * 128 + wr * 64 + m * 16 + fr) * 256 + wc * 32 + 8 * fq;
#pragma unroll
                for (int bj = 0; bj < 2; ++bj) {
                    const f32x4 b0 = *(const f32x4*)(bias + bj * 128 + wc * 32 + 8 * fq), b1 = *(const f32x4*)(bias + bj * 128 + wc * 32 + 8 * fq + 4);
                    const f32x4 a0 = acc[ai][bj][m][0] + b0, a1 = acc[ai][bj][m][1] + b1;
                    v4u w; w.x = pg8::cvt_pk_bf16(gelu_tanh_fast(a0[0]), gelu_tanh_fast(a0[1])); w.y = pg8::cvt_pk_bf16(gelu_tanh_fast(a0[2]), gelu_tanh_fast(a0[3]));
                    w.z = pg8::cvt_pk_bf16(gelu_tanh_fast(a1[0]), gelu_tanh_fast(a1[1])); w.w = pg8::cvt_pk_bf16(gelu_tanh_fast(a1[2]), gelu_tanh_fast(a1[3]));
                    *(v4u*)(rowp + bj * 128) = w;
                }
                asm volatile("" ::: "memory");
            }
    }
};
struct EpiCmp2 {
    static constexpr bool PERM = true, AFTER_DRAIN = false; static constexpr int MID_T = 0;
    unsigned char* ws;
    __device__ __forceinline__ void operator()(const f32x4 (&acc)[2][2][4][2], const pg8::Unit& u, int wr, int wc, int fr, int fq) const {
        if (wc >= 2) return;
        const int kv = u.pm >> 4, c0 = wc * 32 + 8 * fq;
#pragma unroll
        for (int ai = 0; ai < 2; ++ai)
#pragma unroll
            for (int m = 0; m < 4; ++m) {
                const int R = (u.pm & 15) * 256 + ai * 128 + wr * 64 + m * 16 + fr, bg = R >> 9, c = R & 511;
                const f32x4 a0 = acc[ai][0][m][0], a1 = acc[ai][0][m][1];
                if (kv == 0) {
                    v4u w; w.x = pg8::cvt_pk_bf16(a0[0], a0[1]); w.y = pg8::cvt_pk_bf16(a0[2], a0[3]); w.z = pg8::cvt_pk_bf16(a1[0], a1[1]); w.w = pg8::cvt_pk_bf16(a1[2], a1[3]);
                    *(v4u*)((bf16_t*)(ws + O_KC) + ((size_t)bg * 512 + c) * 64 + c0) = w;
                } else {
                    bf16_t* tp = (bf16_t*)(ws + O_VCT) + ((size_t)bg * 64 + c0) * 512 + c;
                    tp[0] = f2bf(a0[0]); tp[512] = f2bf(a0[1]); tp[1024] = f2bf(a0[2]); tp[1536] = f2bf(a0[3]);
                    tp[2048] = f2bf(a1[0]); tp[2560] = f2bf(a1[1]); tp[3072] = f2bf(a1[2]); tp[3584] = f2bf(a1[3]);
                }
            }
    }
};
__device__ __forceinline__ void ph_cmp1(const Params& p, unsigned char* ldsb) {
    const int bid = opq_bid(), gsz = opq_grid();
    unsigned char* ws = p.ws;
    pg8::Gemm g{2048, 1024, p.wbase};
    CmpOrder Sd{gsz, bid, (const char*)(ws + O_CK), (const char*)(ws + O_CV), (const char*)(ws + O_WC1KT), (const char*)(ws + O_WC1VT), (size_t)256 * 1024 * 2};
    EpiCmp1 E{(bf16_t*)(ws + O_HID), (const float*)(ws + O_CB)};
    pg8::gemm_phase<EpiCmp1, CmpOrder, true, true>((PG8_LAS unsigned char*)ldsb, g, Sd, E);
}
__device__ __forceinline__ void ph_cmp2(const Params& p, unsigned char* ldsb) {
    const int bid = opq_bid(), gsz = opq_grid();
    unsigned char* ws = p.ws;
    pg8::Gemm g{256, 256, p.wbase};
    CmpOrder Sd{gsz, bid, (const char*)(ws + O_HID), (const char*)(ws + O_HID) + (size_t)4096 * 256 * 2, (const char*)(ws + O_WC2T), (const char*)(ws + O_WC2T) + (size_t)256 * 256 * 2, (size_t)256 * 256 * 2};
    EpiCmp2 E{ws};
    pg8::gemm_phase<EpiCmp2, CmpOrder, true, true>((PG8_LAS unsigned char*)ldsb, g, Sd, E);
}
__device__ __forceinline__ void prologue_deferred(const Params& p, unsigned char* ldsb, int wi, int nw) {
    const int tid = opq_tid(p.wbase); const int lane = tid & 63, wv = tid >> 6;
    unsigned char* ws = p.ws;
    {
        LAS float* scr = (LAS float*)(LAS unsigned char*)ldsb + wv * (64 * 65);
        constexpr int I_BA = 4 * 16, I_BB = 8 * 16, I_OUT = 16 * 16, I_C1 = 32 * 4;
        for (int it = wi; it < I_BA + I_BB + I_OUT + 2 * I_C1; it += nw) {
            int r = it;
            if (r < I_BA) { p0_transpose_item(p.w_br_a, 256, 1024, (bf16_t*)(ws + O_WBAT), 0, scr, r, lane, 768); continue; } r -= I_BA;
            if (r < I_BB) { p0_transpose_item(p.w_br_b, 512, 1024, (bf16_t*)(ws + O_WBAT) + 256, 0, scr, r, lane, 768); continue; } r -= I_BB;
            if (r < I_OUT) { p0_transpose_item(p.w_out, 1024, 1024, (bf16_t*)(ws + O_WOUTT), 0, scr, r, lane); continue; } r -= I_OUT;
            if (r < I_C1) { p0_transpose_item(p.cmp_w1_k, 2048, 256, (bf16_t*)(ws + O_WC1KT), 0, scr, r, lane); continue; } r -= I_C1;
            p0_transpose_item(p.cmp_w1_v, 2048, 256, (bf16_t*)(ws + O_WC1VT), 0, scr, r, lane);
        }
    }
    float* CB = (float*)(ws + O_CB);
    for (int o = wi; o < 512; o += nw) {
        const int kv = o >> 8, n = o & 255; const float* pos = kv ? p.cmp_pos_v : p.cmp_pos_k; const float* w1 = kv ? p.cmp_w1_v : p.cmp_w1_k;
        float a = 0.f;
#pragma unroll 8
        for (int k = lane; k < 2048; k += 64) a += pos[k] * w1[(size_t)k * 256 + n];
        a = wave_sum(a);
        if (lane == 0) CB[o] = a;
    }
    bf16_t* WC2T = (bf16_t*)(ws + O_WC2T); bf16_t* WRT = (bf16_t*)(ws + O_WRT);
    const int gt = wi * 64 + lane, ngt = nw * 64;
    for (int e = gt; e < 2 * 256 * 256; e += ngt) {
        const int kv = e >> 16, n = (e >> 8) & 255, k = e & 255; const float* w2 = kv ? p.cmp_w2_v : p.cmp_w2_k;
        WC2T[e] = n < 64 ? f2bf(w2[k * 64 + n]) : (bf16_t)0;
    }
    for (int e = gt; e < 48 * 1024; e += ngt) {
        const int col = e >> 10, k = e & 1023;
        float v = 0.f;
        if (col < 4) v = p.w_coarse[k * 4 + col]; else if (col < 36) v = p.w_fine[((size_t)((col - 4) >> 3) * D + k) * 8 + ((col - 4) & 7)];
        const bf16_t hi = f2bf(v); WRT[e] = hi; WRT[48 * 1024 + e] = f2bf(v - bf2f(hi));
    }
}
__device__ __forceinline__ void ph_ln1_route2(const Params& p, unsigned char* ldsb) {
    const int tid = opq_tid(p.wbase), bid = opq_bid(), gsz = opq_grid(); const int lane = tid & 63, wv = tid >> 6, i = lane & 15, h = lane >> 4;
    unsigned char* ws = p.ws;
    bf16_t* H1B = (bf16_t*)(ws + O_H1B); bf16_t* H1L = (bf16_t*)(ws + O_H1L);
    int* LIST = (int*)(ws + O_LIST); float* WTS = (float*)(ws + O_WTS); int* CNT = (int*)(ws + O_CNT); int* ES = (int*)(ws + O_ES);
    const bf16_t* WRT = (const bf16_t*)(ws + O_WRT);
    float* lg = (float*)(ldsb + wv * 3328);
    int* cntl = (int*)(ldsb + 8 * 3328);
    float4 g1v[4], b1v[4];
#pragma unroll
    for (int j = 0; j < 4; ++j) { g1v[j] = *(const float4*)(p.ln1_g + j * 256 + lane * 4); b1v[j] = *(const float4*)(p.ln1_b + j * 256 + lane * 4); }
    const int niter = (T + gsz * 128 - 1) / (gsz * 128);
    for (int it = 0; it < niter; ++it) {
        const int tb = (it * gsz + bid) * 128 + wv * 16;
        const bool inr = tb < T;
        int ex1 = 0, ex2 = 0; float rw1 = 0.f, rw2 = 0.f;
        if (tid < 32) cntl[tid] = 0;
        if (inr) {
#pragma unroll 1
        for (int tt = 0; tt < 16; tt += 2) {
            float v[2][16];
#pragma unroll
            for (int u = 0; u < 2; ++u) { const float* row = p.x + (size_t)(tb + tt + u) * D; const bf16_t* yrow = H1B + (size_t)(tb + tt + u) * D;
#pragma unroll
                for (int j = 0; j < 4; ++j) { const float4 f = *(const float4*)(row + j * 256 + lane * 4); const ushort4 yb = *(const ushort4*)(yrow + j * 256 + lane * 4);
                    v[u][j * 4] = ALPHA * f.x + bf2f(yb.x); v[u][j * 4 + 1] = ALPHA * f.y + bf2f(yb.y); v[u][j * 4 + 2] = ALPHA * f.z + bf2f(yb.z); v[u][j * 4 + 3] = ALPHA * f.w + bf2f(yb.w); } }
            float mu[2], rstd[2];
#pragma unroll
            for (int u = 0; u < 2; ++u) { float sm = 0.f;
#pragma unroll
                for (int j = 0; j < 16; ++j) sm += v[u][j];
                mu[u] = sm; }
            mu[0] = wave_sum(mu[0]) * (1.f / D); mu[1] = wave_sum(mu[1]) * (1.f / D);
#pragma unroll
            for (int u = 0; u < 2; ++u) { float sq = 0.f;
#pragma unroll
                for (int j = 0; j < 16; ++j) { v[u][j] -= mu[u]; sq += v[u][j] * v[u][j]; }
                rstd[u] = sq; }
            rstd[0] = rsqrtf(wave_sum(rstd[0]) * (1.f / D) + LN_EPS); rstd[1] = rsqrtf(wave_sum(rstd[1]) * (1.f / D) + LN_EPS);
#pragma unroll
            for (int u = 0; u < 2; ++u) {
                const int t = tb + tt + u;
#pragma unroll
                for (int j = 0; j < 4; ++j) {
                    const float4 gg = g1v[j], bb = b1v[j];
                    const float a0 = v[u][j * 4] * rstd[u] * gg.x + bb.x, a1 = v[u][j * 4 + 1] * rstd[u] * gg.y + bb.y, a2 = v[u][j * 4 + 2] * rstd[u] * gg.z + bb.z, a3 = v[u][j * 4 + 3] * rstd[u] * gg.w + bb.w;
                    const unsigned h01 = pg8::cvt_pk_bf16(a0, a1), h23 = pg8::cvt_pk_bf16(a2, a3);
                    *(uint2*)(H1B + (size_t)t * D + j * 256 + lane * 4) = make_uint2(h01, h23);
                }
            }
        }
        asm volatile("s_waitcnt vmcnt(0)" ::: "memory");
        f32x4 acc[3] = {{0.f, 0.f, 0.f, 0.f}, {0.f, 0.f, 0.f, 0.f}, {0.f, 0.f, 0.f, 0.f}};
        const bf16_t* ah = H1B + (size_t)(tb + i) * D + 8 * h;
        LAS unsigned char* Wl = (LAS unsigned char*)ldsb + 32768;
#pragma unroll 1
        for (int hh = 0; hh < 2; ++hh) {
            __syncthreads();
#pragma unroll
            for (int q = 0; q < 12; ++q) {
                const int cid = q * NTHREADS + tid, which = cid / 3072, rem = cid - which * 3072, col = rem >> 6, ch = rem & 63;
                const v4u val = *(const v4u*)(WRT + (size_t)which * 48 * 1024 + (size_t)col * D + hh * 512 + ch * 8);
                *(LAS v4u*)(Wl + which * 49152 + col * 1024 + ((ch ^ (col & 15)) << 4)) = val;
            }
            __syncthreads();
#pragma unroll 8
            for (int ks = 0; ks < 16; ++ks) {
                const bf16x8 fh = *(const bf16x8*)(ah + hh * 512 + 32 * ks);
#pragma unroll
                for (int ct = 0; ct < 3; ++ct) {
                    const LAS unsigned char* wp = Wl + (16 * ct + i) * 1024 + (((4 * ks + h) ^ i) << 4);
                    const bf16x8 wh = *(const LAS bf16x8*)wp, wl = *(const LAS bf16x8*)(wp + 49152);
                    acc[ct] = MFMA16(fh, wh, acc[ct]); acc[ct] = MFMA16(fh, wl, acc[ct]);
                }
            }
        }
        asm volatile("s_waitcnt lgkmcnt(0)" ::: "memory");
#pragma unroll
        for (int ct = 0; ct < 3; ++ct)
#pragma unroll
            for (int r = 0; r < 4; ++r) lg[(4 * h + r) * 52 + 16 * ct + i] = acc[ct][r];
        asm volatile("s_waitcnt lgkmcnt(0)" ::: "memory");
        if (lane < 16) {
            const float* L_ = lg + lane * 52;
            float lc[4];
#pragma unroll
            for (int o = 0; o < 4; ++o) lc[o] = L_[o] + p.b_coarse[o];
            int grp = 0; float mx = lc[0];
#pragma unroll
            for (int o = 1; o < 4; ++o) if (lc[o] > mx) { mx = lc[o]; grp = o; }
            float den = 0.f;
#pragma unroll
            for (int o = 0; o < 4; ++o) den += expf(lc[o] - mx);
            const float pg = 1.f / den;
            float f[8];
#pragma unroll
            for (int e = 0; e < 8; ++e) f[e] = L_[4 + grp * 8 + e] + p.b_fine[grp * 8 + e];
            int i1 = 0; float m1 = f[0];
#pragma unroll
            for (int e = 1; e < 8; ++e) if (f[e] > m1) { m1 = f[e]; i1 = e; }
            int i2 = 0; float m2 = -INFINITY;
#pragma unroll
            for (int e = 0; e < 8; ++e) if (e != i1 && f[e] > m2) { m2 = f[e]; i2 = e; }
            const float e2 = expf(m2 - m1);
            const float wa1 = pg / (1.f + e2), wa2 = pg * e2 / (1.f + e2);
            ex1 = grp * 8 + i1; ex2 = grp * 8 + i2; rw1 = wa1; rw2 = wa2;
        }
        }
        __syncthreads();
        int l1 = 0, l2 = 0;
        if (inr && lane < 16) { l1 = atomicAdd(&cntl[ex1], 1); l2 = atomicAdd(&cntl[ex2], 1); }
        __syncthreads();
        if (tid < 32) { const int c_ = cntl[tid]; cntl[32 + tid] = c_ ? atomicAdd(&CNT[tid], c_) : 0; }
        __syncthreads();
        if (inr && lane < 16) {
            const int t = tb + lane;
            const int s1 = cntl[32 + ex1] + l1, s2 = cntl[32 + ex2] + l2;
            LIST[(size_t)ex1 * T + s1] = 2 * t; WTS[2 * t] = rw1; ES[2 * t] = ex1 * 65536 + s1;
            LIST[(size_t)ex2 * T + s2] = 2 * t + 1; WTS[2 * t + 1] = rw2; ES[2 * t + 1] = ex2 * 65536 + s2;
        }
        __syncthreads();
    }
}

constexpr int NSA_NB = 3, NSA_DEPTH = 2;
constexpr int NSA_TB = 64 * 128;
constexpr int NSA_KOFF = 0, NSA_VOFF = NSA_NB * NSA_TB, NSA_WOFF = 2 * NSA_NB * NSA_TB;
constexpr int NSA_WST = 8448;
constexpr int NSA_ST = NSA_WOFF, NSA_STB = 272, NSA_QL = NSA_ST + 256 * NSA_STB, NSA_SELQ = NSA_QL + 32768, NSA_TASK = NSA_SELQ + 2048;
constexpr int NSA_ACT = NSA_TASK + 64, NSA_TL = NSA_TASK + 128, NSA_NCNT = NSA_TASK + 768, NSA_QLST = NSA_TASK + 1024;
static_assert(NSA_ST + 8 * NSA_WST <= NSA_QL && NSA_QLST + 128 * 64 <= 163840 - 64, "NSA LDS map");
__device__ __forceinline__ int nsa_fk(int r) { return ((r >> 3) & 3) | (((r >> 1) & 1) << 2); }
__device__ __forceinline__ int nsa_fv(int r) { return (r >> 1) & 7; }
__device__ __forceinline__ void softmax_fast(f32x4& x0, f32x4& x1, float& m, float& l, f32x4 (&o)[4]) {
    float tm = fmaxf(fmaxf(fmaxf(x0[0], x0[1]), fmaxf(x0[2], x0[3])), fmaxf(fmaxf(x1[0], x1[1]), fmaxf(x1[2], x1[3])));
    tm = hmax4(tm);
    const float mn = fmaxf(m, tm);
    const float alpha = __builtin_amdgcn_exp2f(m - mn);
    m = mn;
#pragma unroll
    for (int r = 0; r < 4; ++r) { x0[r] = __builtin_amdgcn_exp2f(x0[r] - mn); x1[r] = __builtin_amdgcn_exp2f(x1[r] - mn); }
    l = l * alpha + ((x0[0] + x0[1]) + (x0[2] + x0[3])) + ((x1[0] + x1[1]) + (x1[2] + x1[3]));
#pragma unroll
    for (int dt = 0; dt < 4; ++dt) o[dt] = o[dt] * alpha;
}
template <int MODE, bool FAST>
__device__ __forceinline__ void nsa_tile(unsigned char* ldsb, int buf, int tile, int i, int h, int t0, int sq, const bf16x8 (&qf)[2][2], const float (&slope2)[2],
                                         float (&m)[2], float (&l)[2], f32x4 (&acc)[2][4], const float (&invl)[2], bool bit, float* impw, int ncq, float& carry,
                                         f32x4 (&lacc)[2], float gapf) {
    const f32x4 z4 = {0.f, 0.f, 0.f, 0.f};
    const int q = i & 7, r2 = i >> 3, rk0 = 8 * (i >> 2) + (i & 3);
    constexpr bool LMFMA = (MODE == 2 || MODE == 3);
    const v4u ones_u = (i == 0) ? (v4u){0x3F803F80u, 0x3F803F80u, 0x3F803F80u, 0x3F803F80u} : (v4u){0u, 0u, 0u, 0u};
    const bf16x8 ones = __builtin_bit_cast(bf16x8, ones_u);
    if constexpr (LMFMA && FAST) {
        const int key00 = 64 * tile;
        const unsigned char* kbase = ldsb + NSA_KOFF + buf * NSA_TB; const unsigned char* vbase = ldsb + NSA_VOFF + buf * NSA_TB;
        const int dq0 = sq - (key00 + 8 * h);
        bf16x8 kfr[2][2][2];
#pragma unroll
        for (int hf = 0; hf < 2; ++hf) {
            const int ra = 32 * hf + rk0, rb = ra + 4;
            const unsigned char* ka_ = kbase + ra * 128; const unsigned char* kb2_ = kbase + rb * 128;
            const int fa = nsa_fk(ra), fb = nsa_fk(rb);
            kfr[hf][0][0] = *(const bf16x8*)(ka_ + ((h ^ fa) << 4)); kfr[hf][0][1] = *(const bf16x8*)(ka_ + (((4 + h) ^ fa) << 4));
            kfr[hf][1][0] = *(const bf16x8*)(kb2_ + ((h ^ fb) << 4)); kfr[hf][1][1] = *(const bf16x8*)(kb2_ + (((4 + h) ^ fb) << 4));
        }
#pragma unroll
        for (int tt = 0; tt < 2; ++tt) {
            const float shift = slope2[tt] * 64.f * gapf, alpha = __builtin_amdgcn_exp2f(-shift), mref = m[tt] + shift;
            m[tt] = mref;
            const float cbase = ((MODE == 2 && !bit) ? -1e30f : -slope2[tt] * (float)dq0 - mref);
            f32x4 x[2][2];
#pragma unroll
            for (int hf = 0; hf < 2; ++hf) {
                f32x4 c0, c1; const float bh = cbase + (float)(32 * hf) * slope2[tt];
#pragma unroll
                for (int rr = 0; rr < 4; ++rr) { c0[rr] = bh + slope2[tt] * (float)rr; c1[rr] = bh + slope2[tt] * (float)(4 + rr); }
                x[hf][0] = MFMA16(kfr[hf][0][0], qf[tt][0], c0); x[hf][0] = MFMA16(kfr[hf][0][1], qf[tt][1], x[hf][0]);
                x[hf][1] = MFMA16(kfr[hf][1][0], qf[tt][0], c1); x[hf][1] = MFMA16(kfr[hf][1][1], qf[tt][1], x[hf][1]);
            }
            bool big = false;
#pragma unroll
            for (int hf = 0; hf < 2; ++hf)
#pragma unroll
                for (int sb = 0; sb < 2; ++sb)
#pragma unroll
                    for (int rr = 0; rr < 4; ++rr) big |= x[hf][sb][rr] > 30.f;
            float asc = alpha;
            if (__builtin_expect(__any(big), 0)) {
                float tm = fmaxf(fmaxf(fmaxf(x[0][0][0], x[0][0][1]), fmaxf(x[0][0][2], x[0][0][3])), fmaxf(fmaxf(x[0][1][0], x[0][1][1]), fmaxf(x[0][1][2], x[0][1][3])));
                tm = fmaxf(tm, fmaxf(fmaxf(fmaxf(x[1][0][0], x[1][0][1]), fmaxf(x[1][0][2], x[1][0][3])), fmaxf(fmaxf(x[1][1][0], x[1][1][1]), fmaxf(x[1][1][2], x[1][1][3]))));
                tm = hmax4(tm);
                const float up = fmaxf(tm, 0.f);
#pragma unroll
                for (int hf = 0; hf < 2; ++hf)
#pragma unroll
                    for (int sb = 0; sb < 2; ++sb)
#pragma unroll
                        for (int rr = 0; rr < 4; ++rr) x[hf][sb][rr] -= up;
                m[tt] = mref + up; asc = alpha * __builtin_amdgcn_exp2f(-up);
            }
#pragma unroll
            for (int hf = 0; hf < 2; ++hf)
#pragma unroll
                for (int sb = 0; sb < 2; ++sb)
#pragma unroll
                    for (int rr = 0; rr < 4; ++rr) x[hf][sb][rr] = __builtin_amdgcn_exp2f(x[hf][sb][rr]);
#pragma unroll
            for (int dt = 0; dt < 4; ++dt) acc[tt][dt] = acc[tt][dt] * asc;
            lacc[tt] = lacc[tt] * asc;
#pragma unroll
            for (int hf = 0; hf < 2; ++hf) {
                const bf16x8 pf = pack_p(x[hf][0], x[hf][1]);
#pragma unroll
                for (int dt = 0; dt < 4; ++dt) { const int vr = 16 * dt + i; const bf16x8 vfr = *(const bf16x8*)(vbase + vr * 128 + (((4 * hf + h) ^ nsa_fv(vr)) << 4)); acc[tt][dt] = MFMA16(vfr, pf, acc[tt][dt]); }
                lacc[tt] = MFMA16(ones, pf, lacc[tt]);
            }
        }
        return;
    }
    {
            const int key00 = 64 * tile;
            const unsigned char* kbase = ldsb + NSA_KOFF + buf * NSA_TB; const unsigned char* vbase = ldsb + NSA_VOFF + buf * NSA_TB;
            constexpr bool fast = FAST;
            int dq0 = sq - (key00 + 8 * h);
            if (MODE == 4) dq0 += i;
            unsigned vm[2][2] = {{15u, 15u}, {15u, 15u}};
            if (!fast) {
#pragma unroll
                for (int hf = 0; hf < 2; ++hf) {
                    const int kb = key00 + 32 * hf + 8 * h, dq = dq0 - 32 * hf;
                    unsigned a0 = 0u, a1 = 0u;
#pragma unroll
                    for (int rr = 0; rr < 4; ++rr) {
                        bool ok0, ok1;
                        if (MODE <= 1) { ok0 = kb + rr < ncq; ok1 = kb + 4 + rr < ncq; }
                        else if (MODE == 2) { ok0 = bit && dq - rr >= 0; ok1 = bit && dq - 4 - rr >= 0; }
                        else if (MODE == 3) { ok0 = dq - rr >= 0 && dq - rr < 512; ok1 = dq - 4 - rr >= 0 && dq - 4 - rr < 512; }
                        else { ok0 = dq - rr >= 0 && dq - rr <= 128; ok1 = dq - 4 - rr >= 0 && dq - 4 - rr <= 128; }
                        a0 |= ok0 ? (1u << rr) : 0u; a1 |= ok1 ? (1u << rr) : 0u;
                    }
                    vm[hf][0] = a0; vm[hf][1] = a1;
                }
            }
            float Q4[2][2] = {{0.f, 0.f}, {0.f, 0.f}}, E3[2][2] = {{0.f, 0.f}, {0.f, 0.f}};
#pragma unroll
            for (int tt = 0; tt < 2; ++tt) {
                f32x4 x[2][2];
                if (MODE == 4 && tt == 1) {
                    dq0 += 16;
#pragma unroll
                    for (int hf = 0; hf < 2; ++hf) {
                        const int dq = dq0 - 32 * hf;
                        unsigned a0 = 0u, a1 = 0u;
#pragma unroll
                        for (int rr = 0; rr < 4; ++rr) { a0 |= (dq - rr >= 0 && dq - rr <= 128) ? (1u << rr) : 0u; a1 |= (dq - 4 - rr >= 0 && dq - 4 - rr <= 128) ? (1u << rr) : 0u; }
                        vm[hf][0] = a0; vm[hf][1] = a1;
                    }
                }
                const bool cinit = (MODE == 2 || MODE == 3) && fast;
                const float cbase = cinit ? ((MODE == 2 && !bit) ? -1e30f : -slope2[tt] * (float)dq0) : 0.f;
#pragma unroll
                for (int hf = 0; hf < 2; ++hf) {
                    const int ra = 32 * hf + rk0, rb = ra + 4;
                    const unsigned char* ka_ = kbase + ra * 128; const unsigned char* kb2_ = kbase + rb * 128;
                    const int fa = nsa_fk(ra), fb = nsa_fk(rb);
                    const bf16x8 k00 = *(const bf16x8*)(ka_ + ((h ^ fa) << 4)), k01 = *(const bf16x8*)(ka_ + (((4 + h) ^ fa) << 4));
                    const bf16x8 k10 = *(const bf16x8*)(kb2_ + ((h ^ fb) << 4)), k11 = *(const bf16x8*)(kb2_ + (((4 + h) ^ fb) << 4));
                    f32x4 c0 = z4, c1 = z4;
                    if (cinit) {
                        const float bh = cbase + (float)(32 * hf) * slope2[tt];
#pragma unroll
                        for (int rr = 0; rr < 4; ++rr) { c0[rr] = bh + slope2[tt] * (float)rr; c1[rr] = bh + slope2[tt] * (float)(4 + rr); }
                    } else if (MODE >= 2) {
                        const float bh = -slope2[tt] * (float)(dq0 - 32 * hf);
#pragma unroll
                        for (int rr = 0; rr < 4; ++rr) { c0[rr] = ((vm[hf][0] >> rr) & 1u) ? bh + slope2[tt] * (float)rr : -1e30f; c1[rr] = ((vm[hf][1] >> rr) & 1u) ? bh + slope2[tt] * (float)(4 + rr) : -1e30f; }
                    }
                    x[hf][0] = MFMA16(k00, qf[tt][0], c0); x[hf][0] = MFMA16(k01, qf[tt][1], x[hf][0]);
                    x[hf][1] = MFMA16(k10, qf[tt][0], c1); x[hf][1] = MFMA16(k11, qf[tt][1], x[hf][1]);
                }
                if (MODE <= 1) {
#pragma unroll
                    for (int hf = 0; hf < 2; ++hf)
#pragma unroll
                        for (int sb = 0; sb < 2; ++sb)
#pragma unroll
                            for (int rr = 0; rr < 4; ++rr) x[hf][sb][rr] = (fast || ((vm[hf][sb] >> rr) & 1u)) ? x[hf][sb][rr] * QK_C : -1e30f;
                } else {
                }
                if (MODE != 1) {
                    float tm = fmaxf(fmaxf(fmaxf(x[0][0][0], x[0][0][1]), fmaxf(x[0][0][2], x[0][0][3])), fmaxf(fmaxf(x[0][1][0], x[0][1][1]), fmaxf(x[0][1][2], x[0][1][3])));
                    tm = fmaxf(tm, fmaxf(fmaxf(fmaxf(x[1][0][0], x[1][0][1]), fmaxf(x[1][0][2], x[1][0][3])), fmaxf(fmaxf(x[1][1][0], x[1][1][1]), fmaxf(x[1][1][2], x[1][1][3]))));
                    tm = hmax4(tm);
                    const float mn = fmaxf(m[tt], tm), alpha = __builtin_amdgcn_exp2f(m[tt] - mn);
                    m[tt] = mn;
                    const float mnc = fmaxf(mn, -1e29f);
                    float sum = 0.f;
#pragma unroll
                    for (int hf = 0; hf < 2; ++hf)
#pragma unroll
                        for (int sb = 0; sb < 2; ++sb)
#pragma unroll
                            for (int rr = 0; rr < 4; ++rr) {
                                x[hf][sb][rr] = __builtin_amdgcn_exp2f(x[hf][sb][rr] - mnc);
                                sum += x[hf][sb][rr];
                            }
                    if (LMFMA) lacc[tt] = lacc[tt] * alpha; else l[tt] = l[tt] * alpha + sum;
                    if (MODE != 0) {
#pragma unroll
                        for (int dt = 0; dt < 4; ++dt) acc[tt][dt] = acc[tt][dt] * alpha;
                    }
                } else {
                    const float mm = m[tt], il = invl[tt];
#pragma unroll
                    for (int hf = 0; hf < 2; ++hf)
#pragma unroll
                        for (int sb = 0; sb < 2; ++sb) {
#pragma unroll
                            for (int rr = 0; rr < 4; ++rr) {
                                x[hf][sb][rr] = __builtin_amdgcn_exp2f(x[hf][sb][rr] - mm) * il;
                            }
                            Q4[hf][sb] += (x[hf][sb][0] + x[hf][sb][1]) + (x[hf][sb][2] + x[hf][sb][3]); E3[hf][sb] += x[hf][sb][3];
                        }
                }
                if (MODE != 0) {
#pragma unroll
                    for (int hf = 0; hf < 2; ++hf) {
                        const bf16x8 pf = pack_p(x[hf][0], x[hf][1]);
#pragma unroll
                        for (int dt = 0; dt < 4; ++dt) { const int vr = 16 * dt + i; const bf16x8 vfr = *(const bf16x8*)(vbase + vr * 128 + (((4 * hf + h) ^ nsa_fv(vr)) << 4)); acc[tt][dt] = MFMA16(vfr, pf, acc[tt][dt]); }
                        if (LMFMA) lacc[tt] = MFMA16(ones, pf, lacc[tt]);
                    }
                }
            }
            if (MODE == 1) {
#pragma unroll
                for (int hf = 0; hf < 2; ++hf) {
                    float Q4a = Q4[hf][0], Q4b = Q4[hf][1], E3a = E3[hf][0], E3b = E3[hf][1];
                    Q4a += __shfl_xor(Q4a, 8); Q4b += __shfl_xor(Q4b, 8); E3a += __shfl_xor(E3a, 8); E3b += __shfl_xor(E3b, 8);
                    float prevE = __shfl_up(E3b, 16);
                    if (h == 0) prevE = carry;
                    carry = __shfl(E3b, i + 48);
                    const int key0 = key00 + 32 * hf;
                    if (r2 == 0) { impw[q * 132 + (key0 >> 2) + 2 * h] = Q4a + prevE; impw[q * 132 + (key0 >> 2) + 2 * h + 1] = Q4b + E3a; }
                }
            }
            }
}
template <int MODE>
__device__ __forceinline__ void nsa_branch(unsigned char* ldsb, const bf16_t* Kg, const bf16_t* VTg, size_t vstride, int tile_lo, int tile_hi,
                                           int tid, int i, int h, int t0, int sq, const bf16x8 (&qf)[2][2], const float (&slope2)[2],
                                           float (&m)[2], float (&l)[2], f32x4 (&acc)[2][4], const float (&invl)[2],
                                           unsigned sel0, unsigned sel1, unsigned sel2, unsigned sel3, float* impw, int ncq, f32x4 (&lacc)[2]) {
    const f32x4 z4 = {0.f, 0.f, 0.f, 0.f};
    int last_tile = -1;
    const int q = i & 7, r2 = i >> 3, lane = tid & 63, wv = __builtin_amdgcn_readfirstlane(tid >> 6);
    const int srow = 8 * wv + (lane >> 3), pch = lane & 7;
    const bf16_t* gk = Kg + (size_t)srow * 64 + ((pch ^ nsa_fk(srow)) << 3);
    const bf16_t* gv = VTg + (size_t)srow * vstride + ((pch ^ nsa_fv(srow)) << 3);
    const unsigned ldsK = (unsigned)(uintptr_t)(ldsb + NSA_KOFF) + wv * 1024u, ldsV = (unsigned)(uintptr_t)(ldsb + NSA_VOFF) + wv * 1024u;
#define NSA_DMA(tile_, buf_) do { \
        __builtin_amdgcn_global_load_lds((const unsigned*)(gk + (size_t)(tile_) * 64 * 64), (PG8_LAS unsigned*)(uintptr_t)__builtin_amdgcn_readfirstlane((int)(ldsK + (buf_) * NSA_TB)), 16, 0, 0); \
        if (MODE != 0) __builtin_amdgcn_global_load_lds((const unsigned*)(gv + (size_t)(tile_) * 64), (PG8_LAS unsigned*)(uintptr_t)__builtin_amdgcn_readfirstlane((int)(ldsV + (buf_) * NSA_TB)), 16, 0, 0); } while (0)
    const int rk0 = 8 * (i >> 2) + (i & 3);
    if (tile_lo > tile_hi) return;
#pragma unroll
    for (int d = 0; d < NSA_DEPTH; ++d) if (tile_lo + d <= tile_hi) NSA_DMA(tile_lo + d, d);
    int buf = 0; float carry = 0.f;
    const int ncmin = (MODE <= 1) ? (t0 >= 31 ? ((t0 - 31) >> 4) + 1 : 0) : 0, ncmaxw = (MODE <= 1) ? (t0 + 7 >= 31 ? ((t0 + 7 - 31) >> 4) + 1 : 0) : 0;
#pragma unroll 1
    for (int tile = tile_lo; tile <= tile_hi; ++tile) {
        {
            {
        if (MODE != 0) { if (tile + 1 <= tile_hi) asm volatile("s_waitcnt vmcnt(2)" ::: "memory"); else asm volatile("s_waitcnt vmcnt(0)" ::: "memory"); }
        else { if (tile + 1 <= tile_hi) asm volatile("s_waitcnt vmcnt(1)" ::: "memory"); else asm volatile("s_waitcnt vmcnt(0)" ::: "memory"); }
        asm volatile("s_waitcnt lgkmcnt(0)" ::: "memory");
        __builtin_amdgcn_s_barrier();
        asm volatile("" ::: "memory");
        if (tile + NSA_DEPTH <= tile_hi) { const int nb_ = (buf + NSA_DEPTH) % NSA_NB; NSA_DMA(tile + NSA_DEPTH, nb_); }
        bool active = true, bit = true;
        if (MODE == 2) { const int w = tile >> 5; const unsigned sw = w == 0 ? sel0 : (w == 1 ? sel1 : (w == 2 ? sel2 : sel3)); bit = (sw >> (tile & 31)) & 1u; active = __any(bit); }
        if (MODE <= 1) active = 64 * tile < ncmaxw;
        if (MODE == 3) active = (64 * tile + 63 > t0 - 512);
        if (MODE == 4) active = (64 * tile + 63 >= t0 - 128) && (64 * tile <= t0 + 31);
        if (active) {
            const int key00_ = 64 * tile;
            bool fast;
            if (MODE <= 1) fast = key00_ + 63 < ncmin; else if (MODE == 2) fast = key00_ + 63 <= t0; else if (MODE == 3) fast = (key00_ + 63 <= t0) && (t0 + 7 - key00_ < 512); else fast = false;
            if ((MODE == 2 || MODE == 3) && (last_tile < 0 || __any(m[0] < -1e29f || m[1] < -1e29f))) fast = false;
            const float gapf = (float)(tile - last_tile);
            if (fast) nsa_tile<MODE, true>(ldsb, buf, tile, i, h, t0, sq, qf, slope2, m, l, acc, invl, bit, impw, ncq, carry, lacc, gapf);
            else nsa_tile<MODE, false>(ldsb, buf, tile, i, h, t0, sq, qf, slope2, m, l, acc, invl, bit, impw, ncq, carry, lacc, gapf);
            last_tile = tile;
        }
        buf = (buf + 1) % NSA_NB;
            }
        }
    }
    asm volatile("s_waitcnt lgkmcnt(0)" ::: "memory");
    __builtin_amdgcn_s_barrier();
    asm volatile("" ::: "memory");
#undef NSA_DMA
}

__device__ __forceinline__ void ph_dilated2(const Params& p, unsigned char* ldsb) {
    const int tid0 = opq_tid(p.wbase);
    unsigned char* ws = p.ws;
    const bf16_t* QA = (const bf16_t*)(ws + O_QA); const bf16_t* KA = (const bf16_t*)(ws + O_KA); const bf16_t* VAT = (const bf16_t*)(ws + O_VAT);
    bf16_t* OG = (bf16_t*)(ws + O_OG); float* LSE = (float*)(ws + O_LSE);
    int* ctr = (int*)(ws + O_CNT) + 66;
    volatile int* tword = (volatile int*)(ldsb + NSA_TASK);
    for (;;) {
        int tid = tid0; asm volatile("" : "+v"(tid));
        const int lane = tid & 63, wv = __builtin_amdgcn_readfirstlane(tid >> 6), i = lane & 15, h = lane >> 4;
        if (tid == 0) *tword = atomicAdd(ctr, 1);
        __syncthreads();
        const int task = __builtin_amdgcn_readfirstlane(*tword);
        __syncthreads();
        if (task >= NB * 12 * (S / 256)) break;
        int g, qb, idx;
        if (task < 384) { g = 0; qb = 31 - (task >> 4); idx = task & 15; }
        else if (task < 864) { const int t1 = task - 384, c = 8 - t1 / 80, r = t1 % 80;
            if (r < 16) { g = 0; qb = c - 1; idx = r; } else { g = 1; qb = (c - 1) + 8 * ((r - 16) >> 4); idx = (r - 16) & 15; } }
        else { const int t2 = task - 864, c = 2 - t2 / 336, r = t2 % 336;
            if (r < 16) { g = 0; qb = c - 1; idx = r; } else if (r < 80) { g = 1; qb = (c - 1) + 8 * ((r - 16) >> 4); idx = (r - 16) & 15; } else { g = 2; qb = (c - 1) + 2 * ((r - 80) >> 4); idx = (r - 80) & 15; } }
        const int b = idx >> 2, hd = idx & 3, bgh = b * 12 + g * 4 + hd;
        const int sh = 2 * g, d = 1 << sh, L = S >> sh, P0 = qb * 256, r = P0 / L, l0b = P0 - r * L, l0 = l0b + 32 * wv;
        float slope2[2]; slope2[0] = slope2[1] = exp2f(-8.0f * (float)(g * 4 + hd + 1) / 12.0f) * LOG2E * (float)d;
        const size_t base = (size_t)bgh;
        const bf16_t* Qp = QA + (base * S + (size_t)r * L + l0) * 64;
        bf16x8 qf[2][2];
#pragma unroll
        for (int qt = 0; qt < 2; ++qt) { qf[qt][0] = *(const bf16x8*)(Qp + (size_t)(qt * 16 + i) * 64 + 8 * h); qf[qt][1] = *(const bf16x8*)(Qp + (size_t)(qt * 16 + i) * 64 + 8 * h + 32); }
        float m[2] = {-1e30f, -1e30f}, l[2] = {0.f, 0.f}, invl[2] = {0.f, 0.f};
        f32x4 acc[2][4], lacc[2] = {{0.f, 0.f, 0.f, 0.f}, {0.f, 0.f, 0.f, 0.f}};
#pragma unroll
        for (int qt = 0; qt < 2; ++qt)
#pragma unroll
            for (int dt = 0; dt < 4; ++dt) acc[qt][dt] = (f32x4){0.f, 0.f, 0.f, 0.f};
        const int tlo = l0b >= 128 ? (l0b - 128) >> 6 : 0, thi = (l0b + 255) >> 6;
        nsa_branch<4>(ldsb, KA + (base * S + (size_t)r * L) * 64, VAT + (base * 64) * S + (size_t)r * L, S, tlo, thi, tid, i, h, l0, l0, qf, slope2, m, l, acc, invl, 0u, 0u, 0u, 0u, nullptr, 0, lacc);
#pragma unroll
        for (int qt = 0; qt < 2; ++qt) {
            float lt = l[qt]; lt = hsum4(lt);
            const float inv = 1.f / lt;
            const int sp = (l0 + qt * 16 + i) * d + r;
            const size_t t = (size_t)b * S + sp;
            bf16_t* op = OG + (t * 3 + g) * 256 + hd * 64 + 4 * h;
#pragma unroll
            for (int dt = 0; dt < 4; ++dt) {
                const f32x4 v = acc[qt][dt] * inv;
                uint2 w; w.x = pg8::cvt_pk_bf16(v[0], v[1]); w.y = pg8::cvt_pk_bf16(v[2], v[3]);
                *(uint2*)(op + 16 * dt) = w;
            }
            if (h == 0) LSE[t * 12 + g * 4 + hd] = (m[qt] + log2f(lt)) * LN2;
        }
    }
}

__device__ __forceinline__ void nsa_slc_gather(unsigned char* ldsb, const bf16_t* Kg, const bf16_t* VTg, int qblk, int tid, int i, int h, int t0b, int g) {
    const f32x4 z4 = {0.f, 0.f, 0.f, 0.f};
    LAS unsigned char* L_ = (LAS unsigned char*)ldsb;
    const int lane = tid & 63, wv = __builtin_amdgcn_readfirstlane(tid >> 6);
    const int srow = 8 * wv + (lane >> 3), pch = lane & 7;
    const bf16_t* gk = Kg + (size_t)srow * 64 + ((pch ^ nsa_fk(srow)) << 3);
    const bf16_t* gv = VTg + (size_t)srow * S + ((pch ^ nsa_fv(srow)) << 3);
    const unsigned ldsK = (unsigned)(uintptr_t)(ldsb + NSA_KOFF) + wv * 1024u, ldsV = (unsigned)(uintptr_t)(ldsb + NSA_VOFF) + wv * 1024u;
#define SLC_DMA(tile_, buf_) do { \
        __builtin_amdgcn_global_load_lds((const unsigned*)(gk + (size_t)(tile_) * 64 * 64), (PG8_LAS unsigned*)(uintptr_t)__builtin_amdgcn_readfirstlane((int)(ldsK + (buf_) * NSA_TB)), 16, 0, 0); \
        __builtin_amdgcn_global_load_lds((const unsigned*)(gv + (size_t)(tile_) * 64), (PG8_LAS unsigned*)(uintptr_t)__builtin_amdgcn_readfirstlane((int)(ldsV + (buf_) * NSA_TB)), 16, 0, 0); } while (0)
    const LAS unsigned char* QLST = (const LAS unsigned char*)(L_ + NSA_QLST);
    const int rk0 = 8 * (i >> 2) + (i & 3), head = i >> 2;
    const float slope = exp2f(-(float)(g * 4 + head + 1)) * LOG2E;
    const v4u ones_u = (i == 0) ? (v4u){0x3F803F80u, 0x3F803F80u, 0x3F803F80u, 0x3F803F80u} : (v4u){0u, 0u, 0u, 0u};
    const bf16x8 ones = __builtin_bit_cast(bf16x8, ones_u);
    const unsigned long long ltmask = (lane == 0) ? 0ull : (~0ull >> (64 - lane));
    LAS int* TL = (LAS int*)(L_ + NSA_TL);
    int nt;
    {
        const LAS unsigned* ACT = (const LAS unsigned*)(L_ + NSA_ACT); const LAS unsigned char* NC = (const LAS unsigned char*)(L_ + NSA_NCNT);
        const unsigned a0 = __builtin_amdgcn_readfirstlane(ACT[0] | (ACT[1] << 16)), a1 = __builtin_amdgcn_readfirstlane(ACT[2] | (ACT[3] << 16));
        const unsigned a2 = __builtin_amdgcn_readfirstlane(ACT[4] | (ACT[5] << 16)), a3 = __builtin_amdgcn_readfirstlane(ACT[6] | (ACT[7] << 16));
        const unsigned long long mlo = (unsigned long long)a0 | ((unsigned long long)a1 << 32), mhi = (unsigned long long)a2 | ((unsigned long long)a3 << 32);
        const int nlo = __popcll(mlo);
        nt = nlo + __popcll(mhi);
        const int n0 = NC[lane], n1 = NC[64 + lane];
        if ((mlo >> lane) & 1ull) TL[__popcll(mlo & ltmask)] = lane | (n0 << 8);
        if ((mhi >> lane) & 1ull) TL[nlo + __popcll(mhi & ltmask)] = (64 + lane) | (n1 << 8);
        asm volatile("s_waitcnt lgkmcnt(0)" ::: "memory");
    }
    int ta = __builtin_amdgcn_readfirstlane(TL[0]), tb = __builtin_amdgcn_readfirstlane(TL[1]), tc = __builtin_amdgcn_readfirstlane(TL[2]);
    if (0 < nt) SLC_DMA(ta & 255, 0);
    if (1 < nt) SLC_DMA(tb & 255, 1);
    int buf = 0;
#pragma unroll 1
    for (int kt = 0; kt < nt; ++kt) {
        if (kt + 1 < nt) asm volatile("s_waitcnt vmcnt(2)" ::: "memory"); else asm volatile("s_waitcnt vmcnt(0)" ::: "memory");
        asm volatile("s_waitcnt lgkmcnt(0)" ::: "memory");
        __builtin_amdgcn_s_barrier();
        asm volatile("" ::: "memory");
        if (kt + 2 < nt) { const int nb_ = (buf + 2) % NSA_NB; SLC_DMA(tc & 255, nb_); }
        const int tdv = TL[(kt + 3) & 127];
        const int tile = ta & 255, n = ta >> 8, nct = (n + 3) >> 2;
        const LAS unsigned char* kbase = L_ + NSA_KOFF + buf * NSA_TB; const LAS unsigned char* vbase = L_ + NSA_VOFF + buf * NSA_TB;
        const int key00 = 64 * tile;
        const bool diag = tile == qblk;
#pragma unroll 1
        for (int c = wv; c < nct; c += NWAVES) {
            const int k = 4 * c + (i & 3); const bool valid = k < n;
            const int q6 = QLST[tile * 64 + (valid ? k : 0)];
            bf16x8 kf[2][4];
#pragma unroll
            for (int hf = 0; hf < 2; ++hf) {
                const int ra = 32 * hf + rk0, rb = ra + 4;
                const LAS unsigned char* ka_ = kbase + ra * 128; const LAS unsigned char* kb2_ = kbase + rb * 128;
                const int fa = nsa_fk(ra), fb = nsa_fk(rb);
                kf[hf][0] = *(const LAS bf16x8*)(ka_ + ((h ^ fa) << 4)); kf[hf][1] = *(const LAS bf16x8*)(ka_ + (((4 + h) ^ fa) << 4));
                kf[hf][2] = *(const LAS bf16x8*)(kb2_ + ((h ^ fb) << 4)); kf[hf][3] = *(const LAS bf16x8*)(kb2_ + (((4 + h) ^ fb) << 4));
            }
            asm volatile("" ::: "memory");
            const int col = q6 * 4 + head, sqc = t0b + q6;
            const LAS unsigned char* qrow = L_ + NSA_QL + col * 128; const int qsw = col & 7;
            const bf16x8 qf0 = *(const LAS bf16x8*)(qrow + ((h ^ qsw) << 4)), qf1 = *(const LAS bf16x8*)(qrow + (((4 + h) ^ qsw) << 4));
            LAS float* st = (LAS float*)(L_ + NSA_ST + col * NSA_STB);
            f32x4 acc[4];
#pragma unroll
            for (int dt = 0; dt < 4; ++dt) acc[dt] = *(const LAS f32x4*)(st + 16 * dt + 4 * h);
            const float m = st[64];
            f32x4 lacc = z4; if (h == 0) lacc[0] = st[65];
            asm volatile("" ::: "memory");
            const int dq0 = sqc - (key00 + 8 * h);
            f32x4 x[2][2];
#pragma unroll
            for (int hf = 0; hf < 2; ++hf) {
                f32x4 c0, c1; const float bh = -slope * (float)(dq0 - 32 * hf);
#pragma unroll
                for (int rr = 0; rr < 4; ++rr) { c0[rr] = bh + slope * (float)rr; c1[rr] = bh + slope * (float)(4 + rr); }
                x[hf][0] = MFMA16(kf[hf][0], qf0, c0); x[hf][0] = MFMA16(kf[hf][1], qf1, x[hf][0]);
                x[hf][1] = MFMA16(kf[hf][2], qf0, c1); x[hf][1] = MFMA16(kf[hf][3], qf1, x[hf][1]);
            }
            bf16x8 vf[2][4];
#pragma unroll
            for (int hf = 0; hf < 2; ++hf)
#pragma unroll
                for (int dt = 0; dt < 4; ++dt) { const int vr = 16 * dt + i; vf[hf][dt] = *(const LAS bf16x8*)(vbase + vr * 128 + (((4 * hf + h) ^ nsa_fv(vr)) << 4)); }
            asm volatile("" ::: "memory");
            if (diag) {
#pragma unroll
                for (int hf = 0; hf < 2; ++hf)
#pragma unroll
                    for (int sb = 0; sb < 2; ++sb)
#pragma unroll
                        for (int rr = 0; rr < 4; ++rr) if (dq0 - 32 * hf - 4 * sb - rr < 0) x[hf][sb][rr] = -1e30f;
            }
            float tm = fmaxf(fmaxf(fmaxf(x[0][0][0], x[0][0][1]), fmaxf(x[0][0][2], x[0][0][3])), fmaxf(fmaxf(x[0][1][0], x[0][1][1]), fmaxf(x[0][1][2], x[0][1][3])));
            tm = fmaxf(tm, fmaxf(fmaxf(fmaxf(x[1][0][0], x[1][0][1]), fmaxf(x[1][0][2], x[1][0][3])), fmaxf(fmaxf(x[1][1][0], x[1][1][1]), fmaxf(x[1][1][2], x[1][1][3]))));
            tm = hmax4(tm);
            const float mn = fmaxf(m, tm), alpha = __builtin_amdgcn_exp2f(m - mn);
#pragma unroll
            for (int hf = 0; hf < 2; ++hf)
#pragma unroll
                for (int sb = 0; sb < 2; ++sb)
#pragma unroll
                    for (int rr = 0; rr < 4; ++rr) x[hf][sb][rr] = __builtin_amdgcn_exp2f(x[hf][sb][rr] - mn);
#pragma unroll
            for (int dt = 0; dt < 4; ++dt) acc[dt] = acc[dt] * alpha;
            lacc = lacc * alpha;
#pragma unroll
            for (int hf = 0; hf < 2; ++hf) {
                const bf16x8 pf = pack_p(x[hf][0], x[hf][1]);
#pragma unroll
                for (int dt = 0; dt < 4; ++dt) acc[dt] = MFMA16(vf[hf][dt], pf, acc[dt]);
                lacc = MFMA16(ones, pf, lacc);
            }
            if (valid) {
#pragma unroll
                for (int dt = 0; dt < 4; ++dt) *(LAS f32x4*)(st + 16 * dt + 4 * h) = acc[dt];
                if (h == 0) { st[64] = mn; st[65] = lacc[0]; }
            }
        }
        ta = tb; tb = tc; tc = __builtin_amdgcn_readfirstlane(tdv);
        buf = (buf + 1) % NSA_NB;
    }
    asm volatile("s_waitcnt lgkmcnt(0)" ::: "memory");
    __builtin_amdgcn_s_barrier();
    asm volatile("" ::: "memory");
#undef SLC_DMA
}
__device__ __forceinline__ void ph_nsa2(const Params& p, unsigned char* ldsb) {
    const int tid0 = opq_tid(p.wbase);
    unsigned char* ws = p.ws;
    const bf16_t* BQ = (const bf16_t*)(ws + O_BQ); const float* BG = (const float*)(ws + O_BG); bf16_t* YB = (bf16_t*)(ws + O_YAB) + 256;
    const int bg = opq_bid() & 7;
    int* ctr = (int*)(ws + O_CNT) + 96 + bg;
    volatile int* tword = (volatile int*)(ldsb + NSA_TASK);
    int nxt_task = 0; if (tid0 == 0) nxt_task = atomicAdd(ctr, 1);
    for (;;) {
        int tid = tid0; asm volatile("" : "+v"(tid));
        const int lane = tid & 63, wv = __builtin_amdgcn_readfirstlane(tid >> 6), i = lane & 15, h = lane >> 4, q = i & 7, r2 = i >> 3;
        if (tid == 0) *tword = nxt_task;
        __syncthreads();
        const int task = __builtin_amdgcn_readfirstlane(*tword);
        if (tid < 8) ((unsigned*)(ldsb + NSA_ACT))[tid] = 0u;
        __syncthreads();
        if (task >= S / 64) break;
        if (tid == 0) nxt_task = atomicAdd(ctr, 1);
        const int qblk = (S / 64 - 1) - task, b = bg >> 1, g = bg & 1, t0b = qblk * 64, t0 = t0b + 8 * wv, sq = t0 + q;
        const int tq = b * S + sq;
        float* impw = (float*)(ldsb + NSA_WOFF + wv * NSA_WST); unsigned* selw = (unsigned*)(ldsb + NSA_WOFF + wv * NSA_WST + 8192);
        float* otl = (float*)(ldsb + NSA_WOFF + wv * NSA_WST) + lane;
#pragma unroll
        for (int k = 0; k < 17; ++k) if (lane + 64 * k < 1056) impw[lane + 64 * k] = 0.f;
        {
            const bf16_t* qsrc = BQ + ((size_t)b * S + t0b) * 512 + g * 256;
#pragma unroll
            for (int k = 0; k < 4; ++k) {
                const int row = 8 * (4 * wv + k) + (lane >> 3), pc = lane & 7, lc = pc ^ (row & 7);
                __builtin_amdgcn_global_load_lds((const unsigned*)(qsrc + (size_t)(row >> 2) * 512 + (row & 3) * 64 + lc * 8), (PG8_LAS unsigned*)(uintptr_t)__builtin_amdgcn_readfirstlane((int)((unsigned)(uintptr_t)(ldsb + NSA_QL) + (4 * wv + k) * 1024)), 16, 0, 0);
            }
        }
        float gate[2][3];
#pragma unroll
        for (int tt = 0; tt < 2; ++tt)
#pragma unroll
            for (int k = 0; k < 3; ++k) gate[tt][k] = BG[(size_t)tq * 24 + g * 12 + (2 * tt + r2) * 3 + k];
        bf16x8 qf[2][2]; float slope2[2];
#pragma unroll
        for (int tt = 0; tt < 2; ++tt) {
            const bf16_t* qp = BQ + (size_t)tq * 512 + g * 256 + (2 * tt + r2) * 64 + 8 * h;
            qf[tt][0] = *(const bf16x8*)qp; qf[tt][1] = *(const bf16x8*)(qp + 32);
            slope2[tt] = exp2f(-(float)(g * 4 + 2 * tt + r2 + 1)) * LOG2E;
        }
        const f32x4 z4 = {0.f, 0.f, 0.f, 0.f};
        f32x4 acc[2][4], lacc[2] = {{0.f, 0.f, 0.f, 0.f}, {0.f, 0.f, 0.f, 0.f}};
        float m[2], l[2], invl[2] = {0.f, 0.f};
        const int ncq = sq >= 31 ? ((sq - 31) >> 4) + 1 : 0;
        const int ncblk = (t0b + 63 >= 31) ? ((t0b + 63 - 31) >> 4) + 1 : 0;
        const int ctile_hi = ((ncblk + 63) >> 6) - 1;
        const bf16_t* Kc = (const bf16_t*)(ws + O_KC) + (size_t)bg * 512 * 64; const bf16_t* VcT = (const bf16_t*)(ws + O_VCT) + (size_t)bg * 64 * 512;
        m[0] = m[1] = -1e30f; l[0] = l[1] = 0.f;
        nsa_branch<0>(ldsb, Kc, VcT, 512, 0, ctile_hi, tid, i, h, t0, sq, qf, slope2, m, l, acc, invl, 0u, 0u, 0u, 0u, impw, ncq, lacc);
#pragma unroll
        for (int tt = 0; tt < 2; ++tt) { float lt = l[tt]; lt = hsum4(lt); invl[tt] = lt > 0.f ? 1.f / lt : 0.f; }
#pragma unroll
        for (int tt = 0; tt < 2; ++tt)
#pragma unroll
            for (int dt = 0; dt < 4; ++dt) acc[tt][dt] = z4;
        nsa_branch<1>(ldsb, Kc, VcT, 512, 0, ctile_hi, tid, i, h, t0, sq, qf, slope2, m, l, acc, invl, 0u, 0u, 0u, 0u, impw, ncq, lacc);
        unsigned sel0, sel1, sel2, sel3;
        {
            asm volatile("s_waitcnt lgkmcnt(0)" ::: "memory");
            const int qq = lane & 7, jq = lane >> 3, cur = (t0 + qq) >> 6;
            unsigned key[16];
#pragma unroll
            for (int jj = 0; jj < 16; ++jj) {
                const int j = jq * 16 + jj;
                const float sc = impw[qq * 132 + j] + ((j == 0 || j == cur || j == cur - 1) ? 1e4f : 0.f);
                key[jj] = (j <= cur) ? __float_as_uint(sc) : 0u;
            }
            unsigned tau = 0u;
#pragma unroll 1
            for (int bit = 30; bit >= 0; --bit) {
                const unsigned cand = tau | (1u << bit);
                int cnt = 0;
#pragma unroll
                for (int jj = 0; jj < 16; ++jj) cnt += key[jj] >= cand ? 1 : 0;
                cnt += __builtin_amdgcn_update_dpp(0, cnt, 0x128, 0xf, 0xf, false);
                cnt = isum_h4(cnt);
                if (cnt >= 16) tau = cand;
            }
            unsigned mk = 0u;
#pragma unroll
            for (int jj = 0; jj < 16; ++jj) mk |= (key[jj] >= tau && key[jj] != 0u) ? (1u << jj) : 0u;
            ((unsigned*)(ldsb + NSA_SELQ))[(8 * wv + qq) * 8 + jq] = mk;
            atomicOr((unsigned*)(ldsb + NSA_ACT) + jq, mk);
            sel0 = sel1 = sel2 = sel3 = 0u;
        }
        f32x4 oc[2][4];
#pragma unroll
        for (int tt = 0; tt < 2; ++tt) { const float gt = gate[tt][0];
#pragma unroll
            for (int dt = 0; dt < 4; ++dt) oc[tt][dt] = acc[tt][dt] * gt; }
        asm volatile("s_waitcnt lgkmcnt(0)" ::: "memory"); __builtin_amdgcn_s_barrier(); asm volatile("" ::: "memory");
        {
            {
                const unsigned wsel = ((const unsigned*)(ldsb + NSA_SELQ))[lane * 8 + wv];
                const unsigned long long ltm = (lane == 0) ? 0ull : (~0ull >> (64 - lane));
#pragma unroll
                for (int jj = 0; jj < 16; ++jj) {
                    const bool bq = (wsel >> jj) & 1u;
                    const unsigned long long mk = __ballot(bq);
                    if (bq) (ldsb + NSA_QLST)[(16 * wv + jj) * 64 + __popcll(mk & ltm)] = (unsigned char)lane;
                    if (lane == 0) (ldsb + NSA_NCNT)[16 * wv + jj] = (unsigned char)__popcll(mk);
                }
            }
            if (tid < 256) {
                float* st = (float*)(ldsb + NSA_ST + tid * NSA_STB);
#pragma unroll
                for (int e = 0; e < 16; ++e) *(f32x4*)(st + 4 * e) = z4;
                *(f32x4*)(st + 64) = (f32x4){-1e30f, 0.f, 0.f, 0.f};
            }
            asm volatile("s_waitcnt vmcnt(0) lgkmcnt(0)" ::: "memory"); __builtin_amdgcn_s_barrier(); asm volatile("" ::: "memory");
        }
        nsa_slc_gather(ldsb, (const bf16_t*)(ws + O_SK) + (size_t)bg * S * 64, (const bf16_t*)(ws + O_SVT) + (size_t)bg * 64 * S, qblk, tid, i, h, t0b, g);
#pragma unroll
        for (int tt = 0; tt < 2; ++tt) {
            const float* st = (const float*)(ldsb + NSA_ST + ((8 * wv + q) * 4 + 2 * tt + r2) * NSA_STB);
            const float lt = st[65];
            const float sc = lt > 0.f ? gate[tt][1] / lt : 0.f;
#pragma unroll
            for (int dt = 0; dt < 4; ++dt) oc[tt][dt] += *(const f32x4*)(st + 16 * dt + 4 * h) * sc;
        }
        asm volatile("s_waitcnt lgkmcnt(0)" ::: "memory"); __builtin_amdgcn_s_barrier(); asm volatile("" ::: "memory");
#pragma unroll
        for (int tt = 0; tt < 2; ++tt)
#pragma unroll
            for (int dt = 0; dt < 4; ++dt) { otl[64 * (tt * 16 + dt * 4 + 0)] = oc[tt][dt][0]; otl[64 * (tt * 16 + dt * 4 + 1)] = oc[tt][dt][1]; otl[64 * (tt * 16 + dt * 4 + 2)] = oc[tt][dt][2]; otl[64 * (tt * 16 + dt * 4 + 3)] = oc[tt][dt][3]; acc[tt][dt] = z4; }
        lacc[0] = lacc[1] = z4;
        m[0] = m[1] = -1e30f; l[0] = l[1] = 0.f;
        nsa_branch<3>(ldsb, (const bf16_t*)(ws + O_WK) + (size_t)bg * S * 64, (const bf16_t*)(ws + O_WVT) + (size_t)bg * 64 * S, S, qblk >= 8 ? qblk - 8 : 0, qblk, tid, i, h, t0, sq, qf, slope2, m, l, acc, invl, 0u, 0u, 0u, 0u, impw, ncq, lacc);
#pragma unroll
        for (int tt = 0; tt < 2; ++tt) {
            const float lt = __shfl(lacc[tt][0], i);
            const float sc = lt > 0.f ? gate[tt][2] / lt : 0.f;
            bf16_t* op = YB + (size_t)tq * 768 + g * 256 + (2 * tt + r2) * 64 + 4 * h;
#pragma unroll
            for (int dt = 0; dt < 4; ++dt) { f32x4 v = acc[tt][dt] * sc; v[0] += otl[64 * (tt * 16 + dt * 4 + 0)]; v[1] += otl[64 * (tt * 16 + dt * 4 + 1)]; v[2] += otl[64 * (tt * 16 + dt * 4 + 2)]; v[3] += otl[64 * (tt * 16 + dt * 4 + 3)]; uint2 w; w.x = pg8::cvt_pk_bf16(v[0], v[1]); w.y = pg8::cvt_pk_bf16(v[2], v[3]); *(uint2*)(op + 16 * dt) = w; }
        }
    }
}

__device__ __forceinline__ void ph_proj_naive(const Params& p, float* lds) {
    const int tid = opq_tid(p.wbase), bid = opq_bid(), gsz = opq_grid(), tx = tid & 15, ty = tid >> 4;
    constexpr int NTN = 45;
    for (int tile = bid; tile < (T / 128) * NTN; tile += gsz) {
        const int rt = tile / NTN, ct = tile % NTN, row0 = rt * 128, col0 = ct * 128;
        float acc[4][8]; zero_acc(acc);
        const int ncv = (INC - col0) < 128 ? (INC - col0) : 128;
        sgemm_tile<float, float>(acc, p.x + (size_t)(row0 + (tid >> 2)) * D, nullptr, p.w_in + col0, INC, ncv, D, lds, tid);
#pragma unroll
        for (int i = 0; i < 4; ++i)
#pragma unroll
            for (int j = 0; j < 8; ++j) { const int c = col0 + tx * 8 + j; if (c < INC) store_u(p, row0 + ty * 4 + i, c, acc[i][j]); }
    }
}

__device__ __forceinline__ void ph_dilated_naive(const Params& p, float* lds) {
    const int tid = opq_tid(p.wbase), bid = opq_bid(), gsz = opq_grid(); const int lane = tid & 63, wv = tid >> 6;
    float* q = lds + wv * 64;
    const bf16_t* QA = (const bf16_t*)(p.ws + O_QA); const bf16_t* KA = (const bf16_t*)(p.ws + O_KA); const bf16_t* VAT = (const bf16_t*)(p.ws + O_VAT);
    bf16_t* YA = (bf16_t*)(p.ws + O_YA);
    for (int task = bid * NWAVES + wv; task < T * 4; task += gsz * NWAVES) {
        const int t = task >> 2, h = task & 3, b = t / S, s = t % S;
        float Mx = -INFINITY, Wsum = 0.f, Oacc = 0.f;
#pragma unroll 1
        for (int g = 0; g < 3; ++g) {
            const int d = dil_of(g), L = S / d, r = s % d, l = s / d;
            const size_t base = (size_t)((b * 3 + g) * 4 + h);
            const bf16_t* qp = QA + (base * S + (size_t)r * L + l) * 64;
            asm volatile("s_waitcnt lgkmcnt(0)" ::: "memory");
            q[lane] = bf2f(qp[lane]);
            asm volatile("s_waitcnt lgkmcnt(0)" ::: "memory");
            const float slope = exp2f(-8.0f * (float)(g * 4 + h + 1) / 12.0f);
            const int nkeys = (l + 1) < 129 ? (l + 1) : 129;
            const bf16_t* kb = KA + (base * S + (size_t)r * L) * 64;
            const bf16_t* vb = VAT + (base * 64) * S + (size_t)r * L;
            auto kf = [&](int i, const bf16_t*& kr, const bf16_t*& vc, float& bias) -> bool {
                const int kl = l - i;
                kr = kb + (size_t)kl * 64; vc = vb + kl; bias = -slope * (float)(i * d);
                return kl >= 0;
            };
            float og, ls;
            attend_naive(q, nkeys, S, kf, lane, og, ls);
            const float mm = fmaxf(Mx, ls);
            const float a = expf(Mx - mm), bb = expf(ls - mm);
            Oacc = Oacc * a + og * bb; Wsum = Wsum * a + bb; Mx = mm;
        }
        const float o = Oacc / Wsum;
        YA[(size_t)t * 256 + h * 64 + lane] = f2bf(o);
    }
}

__device__ __forceinline__ float gelu_tanh(float v) {
    const float c = 0.7978845608028654f;
    return 0.5f * v * (1.f + tanhf(c * (v + 0.044715f * v * v * v)));
}
__device__ __forceinline__ void ph_cmp1_naive(const Params& p, float* lds) {
    const int tid = opq_tid(p.wbase), bid = opq_bid(), gsz = opq_grid(), tx = tid & 15, ty = tid >> 4;
    float* HID = (float*)(p.ws + O_HID);
    for (int tile = bid; tile < 2 * 8 * 4 * 2; tile += gsz) {
        const int ct = tile & 1, rt = (tile >> 1) & 3, bg = (tile >> 3) & 7, kv = tile >> 6;
        const bf16_t* raw = (const bf16_t*)(p.ws + (kv ? O_CV : O_CK));
        const float* w1 = kv ? p.cmp_w1_v : p.cmp_w1_k; const float* pos = kv ? p.cmp_pos_v : p.cmp_pos_k;
        const int c = rt * 128 + (tid >> 2);
        const bf16_t* arow = (c < 511) ? raw + ((size_t)bg * S + 16 * c) * 64 : nullptr;
        float acc[4][8]; zero_acc(acc);
        sgemm_tile<bf16_t, float>(acc, arow, pos, w1 + ct * 128, 256, 128, 2048, lds, tid);
#pragma unroll
        for (int i = 0; i < 4; ++i)
#pragma unroll
            for (int j = 0; j < 8; ++j) {
                const int cr = rt * 128 + ty * 4 + i, n = ct * 128 + tx * 8 + j;
                HID[((size_t)(kv * 8 + bg) * 512 + cr) * 256 + n] = (cr < 511) ? gelu_tanh(acc[i][j]) : 0.f;
            }
    }
}
__device__ __forceinline__ void ph_cmp2_naive(const Params& p, float* lds) {
    const int tid = opq_tid(p.wbase), bid = opq_bid(), gsz = opq_grid(), tx = tid & 15, ty = tid >> 4;
    const float* HID = (const float*)(p.ws + O_HID);
    bf16_t* KC = (bf16_t*)(p.ws + O_KC); bf16_t* VCT = (bf16_t*)(p.ws + O_VCT);
    for (int tile = bid; tile < 2 * 8 * 4; tile += gsz) {
        const int rt = tile & 3, bg = (tile >> 2) & 7, kv = tile >> 5;
        const float* w2 = kv ? p.cmp_w2_v : p.cmp_w2_k;
        const int c = rt * 128 + (tid >> 2);
        const float* arow = HID + ((size_t)(kv * 8 + bg) * 512 + c) * 256;
        float acc[4][8]; zero_acc(acc);
        sgemm_tile<float, float>(acc, arow, nullptr, w2, 64, 64, 256, lds, tid);
#pragma unroll
        for (int i = 0; i < 4; ++i)
#pragma unroll
            for (int j = 0; j < 8; ++j) {
                const int cr = rt * 128 + ty * 4 + i, n = tx * 8 + j;
                if (n < 64) {
                    const float v = (cr < 511) ? acc[i][j] : 0.f;
                    if (kv == 0) KC[((size_t)bg * 512 + cr) * 64 + n] = f2bf(v);
                    else VCT[((size_t)bg * 64 + n) * 512 + cr] = f2bf(v);
                }
            }
    }
}

__device__ __forceinline__ void ph_nsa_naive(const Params& p, int* wl_all, float* oc_all) {
    const int tid = opq_tid(p.wbase), bid = opq_bid(), gsz = opq_grid(); const int lane = tid & 63, wv = tid >> 6;
    int* wl = wl_all + wv * 16;
    float* ocw = oc_all + wv * 512;
    float* impw = ocw + 256; float* imprw = ocw + 384;
    float* q = oc_all + 4096 + wv * 64;
    const bf16_t* BQ = (const bf16_t*)(p.ws + O_BQ);
    const bf16_t* KC = (const bf16_t*)(p.ws + O_KC); const bf16_t* VCT = (const bf16_t*)(p.ws + O_VCT);
    const bf16_t* SK = (const bf16_t*)(p.ws + O_SK); const bf16_t* SVT = (const bf16_t*)(p.ws + O_SVT);
    const bf16_t* WK = (const bf16_t*)(p.ws + O_WK); const bf16_t* WVT = (const bf16_t*)(p.ws + O_WVT);
    const float* BG = (const float*)(p.ws + O_BG);
    bf16_t* YB = (bf16_t*)(p.ws + O_YB);
    for (int task = bid * NWAVES + wv; task < NB * 2 * S; task += gsz * NWAVES) {
        const int bg = task / S, s = task % S, b = bg >> 1, g = bg & 1, t = b * S + s;
        const int ncmp = (s >= 31) ? ((s - 31) / 16 + 1) : 0;
        impw[lane] = 0.f; impw[lane + 64] = 0.f;
#pragma unroll 1
        for (int r = 0; r < 4; ++r) {
            const bf16_t* qp = BQ + (size_t)t * 512 + g * 256 + r * 64;
            asm volatile("s_waitcnt lgkmcnt(0)" ::: "memory");
            q[lane] = bf2f(qp[lane]);
            asm volatile("s_waitcnt lgkmcnt(0)" ::: "memory");
            const bf16_t* kb = KC + (size_t)bg * 512 * 64;
            const bf16_t* vb = VCT + (size_t)bg * 64 * 512;
            float m = -INFINITY;
            for (int c0 = 0; c0 < ncmp; c0 += 64) {
                const int c = c0 + lane;
                if (c < ncmp) {
                    const float sc = dot64(q, kb + (size_t)c * 64);
                    m = fmaxf(m, sc * 0.125f);
                }
            }
            m = wave_max(m);
            if (!(m > -INFINITY)) m = 0.f;
            float l = 0.f, ocv = 0.f;
            imprw[lane] = 0.f; imprw[lane + 64] = 0.f;
#pragma unroll 1
            for (int half = 0; half < 2; ++half) {
                float op[32];
#pragma unroll
                for (int d = 0; d < 32; ++d) op[d] = 0.f;
                l = 0.f;
                float carry = 0.f;
#pragma unroll 1
                for (int ch = 0; ch * 64 < ncmp; ++ch) {
                    const int c = ch * 64 + lane;
                    float pe = 0.f;
                    if (c < ncmp) {
                        const float sc = dot64(q, kb + (size_t)c * 64);
                        pe = expf(sc * 0.125f - m);
                        l += pe;
                        const bf16_t* vh = vb + (size_t)(half * 32) * 512 + c;
#pragma unroll
                        for (int d = 0; d < 32; ++d) op[d] += pe * bf2f(vh[(size_t)d * 512]);
                    }
                    if (half == 0) {
                        float quad = pe + __shfl_xor(pe, 1);
                        quad += __shfl_xor(quad, 2);
                        float prev = __shfl_up(pe, 1);
                        if (lane == 0) prev = carry;
                        if ((lane & 3) == 0) imprw[16 * ch + (lane >> 2)] = quad + prev;
                        carry = __shfl(pe, 63);
                    }
                }
                const float rr = tr_reduce32(op, lane);
                if ((lane >> 5) == half) ocv = rr;
            }
            l = wave_sum(l);
            const float inv = 1.f / fmaxf(l, TINY);
            ocw[r * 64 + lane] = ocv * inv;
            asm volatile("s_waitcnt lgkmcnt(0)" ::: "memory");
            impw[lane] += imprw[lane] * inv; impw[lane + 64] += imprw[lane + 64] * inv;
            asm volatile("s_waitcnt lgkmcnt(0)" ::: "memory");
        }
        float sc0 = impw[lane], sc1 = impw[lane + 64];
        const int cur = s >> 6;
        const int j0 = lane, j1 = lane + 64;
        const bool v0 = j0 <= cur, v1 = j1 <= cur;
        const bool f0 = (j0 == 0) || (j0 == cur) || (j0 == cur - 1), f1 = (j1 == cur) || (j1 == cur - 1);
        sc0 = v0 ? (sc0 + (f0 ? 1e4f : 0.f)) : -INFINITY;
        sc1 = v1 ? (sc1 + (f1 ? 1e4f : 0.f)) : -INFINITY;
        int rk0 = 0, rk1 = 0;
        for (int i = 0; i < 64; ++i) {
            const float a = __shfl(sc0, i), bb = __shfl(sc1, i);
            rk0 += (a > sc0 || (a == sc0 && i < j0)) ? 1 : 0;
            rk0 += (bb > sc0) ? 1 : 0;
            rk1 += (a > sc1 || (a == sc1)) ? 1 : 0;
            rk1 += (bb > sc1 || (bb == sc1 && (i + 64) < j1)) ? 1 : 0;
        }
        const bool sel0 = v0 && rk0 < 16, sel1 = v1 && rk1 < 16;
        const unsigned long long mk0 = __ballot(sel0), mk1 = __ballot(sel1);
        const unsigned long long below = (lane == 0) ? 0ull : (~0ull >> (64 - lane));
        const int n0 = __popcll(mk0);
        if (sel0) wl[__popcll(mk0 & below)] = j0;
        if (sel1) wl[n0 + __popcll(mk1 & below)] = j1;
        const int nsel = n0 + __popcll(mk1);
        asm volatile("s_waitcnt lgkmcnt(0)" ::: "memory");
#pragma unroll 1
        for (int r = 0; r < 4; ++r) {
            const bf16_t* qp = BQ + (size_t)t * 512 + g * 256 + r * 64;
            asm volatile("s_waitcnt lgkmcnt(0)" ::: "memory");
            q[lane] = bf2f(qp[lane]);
            asm volatile("s_waitcnt lgkmcnt(0)" ::: "memory");
            const float slope = exp2f(-(float)(g * 4 + r + 1));
            float os, ow, dummy;
            {
                const bf16_t* kb = SK + (size_t)bg * S * 64; const bf16_t* vb = SVT + (size_t)bg * 64 * S;
                auto kf = [&](int i, const bf16_t*& kr, const bf16_t*& vc, float& bias) -> bool {
                    const int j = wl[i >> 6];
                    const int pos = j * 64 + (i & 63);
                    kr = kb + (size_t)pos * 64; vc = vb + pos; bias = -slope * (float)(s - pos);
                    return pos <= s;
                };
                attend_naive(q, nsel * 64, S, kf, lane, os, dummy);
            }
            {
                const bf16_t* kb = WK + (size_t)bg * S * 64; const bf16_t* vb = WVT + (size_t)bg * 64 * S;
                auto kf = [&](int i, const bf16_t*& kr, const bf16_t*& vc, float& bias) -> bool {
                    const int pos = s - i;
                    kr = kb + (size_t)pos * 64; vc = vb + pos; bias = -slope * (float)i;
                    return pos >= 0;
                };
                attend_naive(q, 512, S, kf, lane, ow, dummy);
            }
            const float* gp = BG + (size_t)t * 24 + g * 12 + r * 3;
            const float o = gp[0] * ocw[r * 64 + lane] + gp[1] * os + gp[2] * ow;
            YB[(size_t)t * 512 + g * 256 + r * 64 + lane] = f2bf(o);
        }
        asm volatile("s_waitcnt lgkmcnt(0)" ::: "memory");
    }
}

__device__ __forceinline__ void ph_merge_naive(const Params& p, float* lds) {
    const int tid = opq_tid(p.wbase), bid = opq_bid(), gsz = opq_grid(), tx = tid & 15, ty = tid >> 4;
    const bf16_t* YA = (const bf16_t*)(p.ws + O_YA); const bf16_t* YB = (const bf16_t*)(p.ws + O_YB); const bf16_t* MG = (const bf16_t*)(p.ws + O_MG);
    bf16_t* MERGED = (bf16_t*)(p.ws + O_MERGED);
    for (int tile = bid; tile < (T / 128) * 8; tile += gsz) {
        const int rt = tile >> 3, ct = tile & 7, row0 = rt * 128, col0 = ct * 128;
        float acc1[4][8], acc2[4][8]; zero_acc(acc1); zero_acc(acc2);
        sgemm_tile<bf16_t, float>(acc1, YA + (size_t)(row0 + (tid >> 2)) * 256, nullptr, p.w_br_a + col0, D, 128, 256, lds, tid);
        sgemm_tile<bf16_t, float>(acc2, YB + (size_t)(row0 + (tid >> 2)) * 512, nullptr, p.w_br_b + col0, D, 128, 512, lds, tid);
#pragma unroll
        for (int i = 0; i < 4; ++i) {
            const int r = row0 + ty * 4 + i, c = col0 + tx * 8;
            const uint4 ga = *(const uint4*)(MG + (size_t)r * 2048 + c), gb = *(const uint4*)(MG + (size_t)r * 2048 + 1024 + c);
            const unsigned gau[4] = {ga.x, ga.y, ga.z, ga.w}, gbu[4] = {gb.x, gb.y, gb.z, gb.w};
            unsigned o[4];
#pragma unroll
            for (int j = 0; j < 4; ++j) {
                const float lo = __uint_as_float(gau[j] << 16) * acc1[i][2 * j] + __uint_as_float(gbu[j] << 16) * acc2[i][2 * j];
                const float hi = __uint_as_float(gau[j] & 0xffff0000u) * acc1[i][2 * j + 1] + __uint_as_float(gbu[j] & 0xffff0000u) * acc2[i][2 * j + 1];
                o[j] = (unsigned)f2bf(lo) | ((unsigned)f2bf(hi) << 16);
            }
            *(uint4*)(MERGED + (size_t)r * D + c) = make_uint4(o[0], o[1], o[2], o[3]);
            asm volatile("" ::: "memory");
        }
    }
}
__device__ __forceinline__ void ph_wout_naive(const Params& p, float* lds) {
    const int tid = opq_tid(p.wbase), bid = opq_bid(), gsz = opq_grid(), tx = tid & 15, ty = tid >> 4;
    const bf16_t* MERGED = (const bf16_t*)(p.ws + O_MERGED);
    for (int tile = bid; tile < (T / 128) * 8; tile += gsz) {
        const int rt = tile >> 3, ct = tile & 7, row0 = rt * 128, col0 = ct * 128;
        float acc[4][8]; zero_acc(acc);
        sgemm_tile<bf16_t, float>(acc, MERGED + (size_t)(row0 + (tid >> 2)) * D, nullptr, p.w_out + col0, D, 128, D, lds, tid);
#pragma unroll
        for (int i = 0; i < 4; ++i) {
            const size_t off = (size_t)(row0 + ty * 4 + i) * D + col0 + tx * 8;
            const float4 x0 = *(const float4*)(p.x + off), x1 = *(const float4*)(p.x + off + 4);
            *(float4*)(p.out + off) = make_float4(ALPHA * x0.x + acc[i][0], ALPHA * x0.y + acc[i][1], ALPHA * x0.z + acc[i][2], ALPHA * x0.w + acc[i][3]);
            *(float4*)(p.out + off + 4) = make_float4(ALPHA * x1.x + acc[i][4], ALPHA * x1.y + acc[i][5], ALPHA * x1.z + acc[i][6], ALPHA * x1.w + acc[i][7]);
            asm volatile("" ::: "memory");
        }
    }
}
__device__ __forceinline__ void ph_ln1_route(const Params& p, float* lds) {
    const int tid = opq_tid(p.wbase), bid = opq_bid(), gsz = opq_grid(); const int lane = tid & 63, wv = tid >> 6;
    float* hrow = lds + wv * 1024;
    bf16_t* H1B = (bf16_t*)(p.ws + O_H1B);
    int* LIST = (int*)(p.ws + O_LIST); float* WTS = (float*)(p.ws + O_WTS); int* CNT = (int*)(p.ws + O_CNT); int* ES = (int*)(p.ws + O_ES);
    for (int t = bid * NWAVES + wv; t < T; t += gsz * NWAVES) {
        float* row = p.out + (size_t)t * D;
        float v[16];
#pragma unroll
        for (int j = 0; j < 4; ++j) { const float4 f = *(const float4*)(row + j * 256 + lane * 4); v[j * 4] = f.x; v[j * 4 + 1] = f.y; v[j * 4 + 2] = f.z; v[j * 4 + 3] = f.w; }
        float sm = 0.f;
#pragma unroll
        for (int j = 0; j < 16; ++j) sm += v[j];
        const float mu = wave_sum(sm) * (1.f / D);
        float sq = 0.f;
#pragma unroll
        for (int j = 0; j < 16; ++j) { v[j] -= mu; sq += v[j] * v[j]; }
        const float rstd = rsqrtf(wave_sum(sq) * (1.f / D) + LN_EPS);
#pragma unroll
        for (int j = 0; j < 4; ++j) {
#pragma unroll
            for (int e = 0; e < 4; ++e) { const int k = j * 256 + lane * 4 + e; v[j * 4 + e] = v[j * 4 + e] * rstd * p.ln1_g[k] + p.ln1_b[k]; }
            *(float4*)(row + j * 256 + lane * 4) = make_float4(v[j * 4], v[j * 4 + 1], v[j * 4 + 2], v[j * 4 + 3]);
            ushort4 hb; hb.x = f2bf(v[j * 4]); hb.y = f2bf(v[j * 4 + 1]); hb.z = f2bf(v[j * 4 + 2]); hb.w = f2bf(v[j * 4 + 3]);
            *(ushort4*)(H1B + (size_t)t * D + j * 256 + lane * 4) = hb;
        }
        asm volatile("s_waitcnt lgkmcnt(0)" ::: "memory");
#pragma unroll
        for (int j = 0; j < 16; ++j) hrow[j * 64 + lane] = v[j];
        asm volatile("s_waitcnt lgkmcnt(0)" ::: "memory");
        float lc[4], lf[4][8];
#pragma unroll
        for (int o = 0; o < 4; ++o) { lc[o] = 0.f;
#pragma unroll
            for (int e = 0; e < 8; ++e) lf[o][e] = 0.f; }
#pragma unroll 1
        for (int j = 0; j < 16; ++j) {
            const int k = (j >> 2) * 256 + lane * 4 + (j & 3);
            const float hv = hrow[j * 64 + lane];
            const float4 wc = *(const float4*)(p.w_coarse + (size_t)k * 4);
            lc[0] += hv * wc.x; lc[1] += hv * wc.y; lc[2] += hv * wc.z; lc[3] += hv * wc.w;
#pragma unroll
            for (int gg = 0; gg < 4; ++gg) {
                const float4 wa = *(const float4*)(p.w_fine + ((size_t)gg * D + k) * 8), wb = *(const float4*)(p.w_fine + ((size_t)gg * D + k) * 8 + 4);
                lf[gg][0] += hv * wa.x; lf[gg][1] += hv * wa.y; lf[gg][2] += hv * wa.z; lf[gg][3] += hv * wa.w;
                lf[gg][4] += hv * wb.x; lf[gg][5] += hv * wb.y; lf[gg][6] += hv * wb.z; lf[gg][7] += hv * wb.w;
            }
        }
#pragma unroll
        for (int o = 0; o < 4; ++o) { lc[o] = wave_sum(lc[o]) + p.b_coarse[o];
#pragma unroll
            for (int e = 0; e < 8; ++e) lf[o][e] = wave_sum(lf[o][e]) + p.b_fine[o * 8 + e]; }
        int grp = 0; float mx = lc[0];
#pragma unroll
        for (int o = 1; o < 4; ++o) if (lc[o] > mx) { mx = lc[o]; grp = o; }
        float den = 0.f;
#pragma unroll
        for (int o = 0; o < 4; ++o) den += expf(lc[o] - mx);
        const float pg = 1.f / den;
        float f[8];
#pragma unroll
        for (int e = 0; e < 8; ++e) f[e] = grp == 0 ? lf[0][e] : (grp == 1 ? lf[1][e] : (grp == 2 ? lf[2][e] : lf[3][e]));
        int i1 = 0; float m1 = f[0];
#pragma unroll
        for (int e = 1; e < 8; ++e) if (f[e] > m1) { m1 = f[e]; i1 = e; }
        int i2 = -1; float m2 = -INFINITY;
#pragma unroll
        for (int e = 0; e < 8; ++e) if (e != i1 && f[e] > m2) { m2 = f[e]; i2 = e; }
        const float e2 = expf(m2 - m1);
        const float wa1 = pg / (1.f + e2), wa2 = pg * e2 / (1.f + e2);
        if (lane == 0) {
            const int ex1 = grp * 8 + i1, ex2 = grp * 8 + i2;
            const int s1 = atomicAdd(&CNT[ex1], 1); LIST[(size_t)ex1 * T + s1] = 2 * t; WTS[2 * t] = wa1; ES[2 * t] = ex1 * 65536 + s1;
            const int s2 = atomicAdd(&CNT[ex2], 1); LIST[(size_t)ex2 * T + s2] = 2 * t + 1; WTS[2 * t + 1] = wa2; ES[2 * t + 1] = ex2 * 65536 + s2;
        }
    }
}
__device__ __forceinline__ void ph_moe_up_naive(const Params& p, float* lds) {
    const int tid = opq_tid(p.wbase), bid = opq_bid(), gsz = opq_grid(), tx = tid & 15, ty = tid >> 4;
    const int* LIST = (const int*)(p.ws + O_LIST); const int* CNT = (const int*)(p.ws + O_CNT);
    bf16_t* ACT = (bf16_t*)(p.ws + O_ACT);
    int total = 0;
    for (int e = 0; e < NEXP; ++e) total += ((CNT[e] + 127) >> 7) * 4;
    for (int tile = bid; tile < total; tile += gsz) {
        int e = 0, rem = tile;
        for (; e < NEXP; ++e) { const int n = ((CNT[e] + 127) >> 7) * 4; if (rem < n) break; rem -= n; }
        const int blk = rem >> 2, ct = rem & 3, cnt = CNT[e];
        const int lr = blk * 128 + (tid >> 2);
        const float* arow = (lr < cnt) ? p.out + (size_t)(LIST[(size_t)e * T + lr] >> 1) * D : nullptr;
        float ag[4][8], au[4][8]; zero_acc(ag); zero_acc(au);
        const float* W = p.w_gate_up + (size_t)e * D * 1024;
        sgemm_tile<float, float>(ag, arow, nullptr, W + ct * 128, 1024, 128, D, lds, tid);
        sgemm_tile<float, float>(au, arow, nullptr, W + 512 + ct * 128, 1024, 128, D, lds, tid);
#pragma unroll
        for (int i = 0; i < 4; ++i) {
            const int rr = blk * 128 + ty * 4 + i;
            if (rr < cnt) {
                const int aid = LIST[(size_t)e * T + rr];
                unsigned o[4];
#pragma unroll
                for (int j = 0; j < 4; ++j) {
                    const float g0 = ag[i][2 * j], g1 = ag[i][2 * j + 1];
                    o[j] = (unsigned)f2bf(g0 / (1.f + expf(-g0)) * au[i][2 * j]) | ((unsigned)f2bf(g1 / (1.f + expf(-g1)) * au[i][2 * j + 1]) << 16);
                }
                *(uint4*)(ACT + (size_t)aid * DEXP + ct * 128 + tx * 8) = make_uint4(o[0], o[1], o[2], o[3]);
            }
            asm volatile("" ::: "memory");
        }
    }
}
__device__ __forceinline__ void ph_moe_down_naive(const Params& p, float* lds) {
    const int tid = opq_tid(p.wbase), bid = opq_bid(), gsz = opq_grid(), tx = tid & 15, ty = tid >> 4;
    const int* LIST = (const int*)(p.ws + O_LIST); const int* CNT = (const int*)(p.ws + O_CNT);
    const bf16_t* ACT = (const bf16_t*)(p.ws + O_ACT); bf16_t* YE = (bf16_t*)(p.ws + O_YE);
    int total = 0;
    for (int e = 0; e < NEXP; ++e) total += ((CNT[e] + 127) >> 7) * 8;
    for (int tile = bid; tile < total; tile += gsz) {
        int e = 0, rem = tile;
        for (; e < NEXP; ++e) { const int n = ((CNT[e] + 127) >> 7) * 8; if (rem < n) break; rem -= n; }
        const int blk = rem >> 3, ct = rem & 7, cnt = CNT[e];
        const int lr = blk * 128 + (tid >> 2);
        const bf16_t* arow = (lr < cnt) ? ACT + (size_t)LIST[(size_t)e * T + lr] * DEXP : nullptr;
        float acc[4][8]; zero_acc(acc);
        sgemm_tile<bf16_t, float>(acc, arow, nullptr, p.w_down + (size_t)e * DEXP * D + ct * 128, D, 128, DEXP, lds, tid);
#pragma unroll
        for (int i = 0; i < 4; ++i) {
            const int rr = blk * 128 + ty * 4 + i;
            if (rr < cnt) {
                const int aid = LIST[(size_t)e * T + rr];
                unsigned o[4];
#pragma unroll
                for (int j = 0; j < 4; ++j) o[j] = (unsigned)f2bf(acc[i][2 * j]) | ((unsigned)f2bf(acc[i][2 * j + 1]) << 16);
                *(uint4*)(YE + (size_t)aid * D + ct * 128 + tx * 8) = make_uint4(o[0], o[1], o[2], o[3]);
            }
            asm volatile("" ::: "memory");
        }
    }
}
__device__ __forceinline__ void ph_final(const Params& p) {
    const int tid = opq_tid(p.wbase), bid = opq_bid(), gsz = opq_grid(); const int lane = tid & 63, wv = tid >> 6;
    const bf16_t* YE = (const bf16_t*)(p.ws + O_YE); const float* WTS = (const float*)(p.ws + O_WTS);
    for (int t = bid * NWAVES + wv; t < T; t += gsz * NWAVES) {
        float* row = p.out + (size_t)t * D;
        const float w0 = WTS[2 * t], w1 = WTS[2 * t + 1];
        float v[16];
#pragma unroll
        for (int j = 0; j < 4; ++j) {
            const float4 f = *(const float4*)(row + j * 256 + lane * 4);
            const ushort4 a = *(const ushort4*)(YE + (size_t)(2 * t) * D + j * 256 + lane * 4), bq = *(const ushort4*)(YE + (size_t)(2 * t + 1) * D + j * 256 + lane * 4);
            v[j * 4] = ALPHA * f.x + w0 * bf2f(a.x) + w1 * bf2f(bq.x); v[j * 4 + 1] = ALPHA * f.y + w0 * bf2f(a.y) + w1 * bf2f(bq.y);
            v[j * 4 + 2] = ALPHA * f.z + w0 * bf2f(a.z) + w1 * bf2f(bq.z); v[j * 4 + 3] = ALPHA * f.w + w0 * bf2f(a.w) + w1 * bf2f(bq.w);
        }
        float sm = 0.f;
#pragma unroll
        for (int j = 0; j < 16; ++j) sm += v[j];
        const float mu = wave_sum(sm) * (1.f / D);
        float sq = 0.f;
#pragma unroll
        for (int j = 0; j < 16; ++j) { v[j] -= mu; sq += v[j] * v[j]; }
        const float rstd = rsqrtf(wave_sum(sq) * (1.f / D) + LN_EPS);
#pragma unroll
        for (int j = 0; j < 4; ++j) {
#pragma unroll
            for (int e = 0; e < 4; ++e) { const int k = j * 256 + lane * 4 + e; v[j * 4 + e] = v[j * 4 + e] * rstd * p.ln2_g[k] + p.ln2_b[k]; }
            *(float4*)(row + j * 256 + lane * 4) = make_float4(v[j * 4], v[j * 4 + 1], v[j * 4 + 2], v[j * 4 + 3]);
        }
    }
}


#define LDS_WAIT() asm volatile("s_waitcnt lgkmcnt(0)" ::: "memory")
#define VM_WAIT() asm volatile("s_waitcnt vmcnt(0)" ::: "memory")
#define XB_TMO      128
#define XB_XCNT(j)  (256  + 64 * (j))
#define XB_XSUB(j)  (1280 + 64 * (j))
#define XB_XGEN(j)  (2304 + 64 * (j))
#define XB_TOP      3328
#define XB_TOPGEN   3392
#define XCD_BAR_WORDS 3456
#define XB_SPIN_CAP (1u << 18)

__device__ __forceinline__ unsigned xb_ld(unsigned* p)              { return __hip_atomic_load(p, __ATOMIC_RELAXED, __HIP_MEMORY_SCOPE_AGENT); }
__device__ __forceinline__ unsigned xb_add(unsigned* p, unsigned v) { return __hip_atomic_fetch_add(p, v, __ATOMIC_RELAXED, __HIP_MEMORY_SCOPE_AGENT); }
__device__ __forceinline__ unsigned xb_xcc_id() { return (unsigned)__builtin_amdgcn_s_getreg((3 << 11) | 20) & 0xFu; }
#define XB_SPIN(cond, bar) do { unsigned _sp = 0; while (cond) { __builtin_amdgcn_s_sleep(1); \
    if ((++_sp & 255u) == 0u) { if (xb_ld(&(bar)[XB_TMO])) break; if (_sp > XB_SPIN_CAP) { atomicAdd(&(bar)[XB_TMO], 1u); break; } } } } while (0)

struct XcdBarrier {
    unsigned* bar; unsigned x;
    volatile LAS unsigned* st;
};

__device__ __forceinline__ XcdBarrier xcd_barrier_post(unsigned* bar, volatile LAS unsigned* st) {
    XcdBarrier b; b.bar = bar; b.x = xb_xcc_id(); b.st = st;
    if (threadIdx.x == 0) (void)xb_add(&bar[XB_XCNT(b.x)], 1u);
    return b;
}
__device__ __forceinline__ void xcd_barrier_complete(unsigned* bar, unsigned x, unsigned& nloc, unsigned& nx) {
    const unsigned G = gridDim.x * gridDim.y * gridDim.z;
    unsigned sum, cnt, mine, sp = 0u;
    for (;;) {
        sum = 0u; cnt = 0u; mine = 0u;
#pragma unroll
        for (unsigned j = 0; j < 16; ++j) { const unsigned c = xb_ld(&bar[XB_XCNT(j)]); sum += c; cnt += (c > 0u) ? 1u : 0u; mine = (j == x) ? c : mine; }
        if (sum == G) break;
        __builtin_amdgcn_s_sleep(1);
        if ((++sp & 255u) == 0u) { if (xb_ld(&bar[XB_TMO])) break; if (sp > XB_SPIN_CAP) { atomicAdd(&bar[XB_TMO], 1u); break; } }
    }
    nloc = mine > 0u ? mine : 1u; nx = cnt > 0u ? cnt : 1u;
}

__device__ __forceinline__ void xcd_barrier(const XcdBarrier& b) {
    asm volatile("s_waitcnt vmcnt(0)" ::: "memory");
    __syncthreads();
    if (threadIdx.x == 0) {
        unsigned* bar = b.bar;
        __builtin_amdgcn_s_waitcnt(0);
        unsigned nloc = b.st[0], nx = b.st[1];
        if (nloc == 0u) { xcd_barrier_complete(bar, b.x, nloc, nx); b.st[0] = nloc; b.st[1] = nx; }
        const unsigned old = xb_add(&bar[XB_XSUB(b.x)], 1u);
        const unsigned gen = old / nloc;
        if (old + 1u == (gen + 1u) * nloc) {
            __builtin_amdgcn_fence(__ATOMIC_RELEASE, "agent");
            asm volatile("s_waitcnt vmcnt(0)" ::: "memory");
            const unsigned og = xb_add(&bar[XB_TOP], 1u);
            const unsigned tg = og / nx;
            if (og + 1u == (tg + 1u) * nx) xb_add(&bar[XB_TOPGEN], 1u);
            else XB_SPIN(xb_ld(&bar[XB_TOPGEN]) == tg, bar);
            __builtin_amdgcn_fence(__ATOMIC_ACQUIRE, "agent");
            xb_add(&bar[XB_XGEN(b.x)], 1u);
            asm volatile("s_waitcnt vmcnt(0)" ::: "memory");
        } else {
            XB_SPIN(xb_ld(&bar[XB_XGEN(b.x)]) == gen, bar);
            __builtin_amdgcn_fence(__ATOMIC_ACQUIRE, "agent");
            asm volatile("s_waitcnt vmcnt(0)" ::: "memory");
        }
    }
    __syncthreads();
}


constexpr int NPHASE = 11;
template <int LO, int HI> __global__ void __launch_bounds__(NTHREADS, 2) mega(Params p_arg) {
    __shared__ __attribute__((aligned(16))) unsigned char ldsb[LDS_BYTES];
    const int wbase_ = __builtin_amdgcn_readfirstlane((int)(threadIdx.x & ~63u));
    (void)p_arg;
    float* lds = (float*)ldsb;
    int* wl = (int*)(lds + 8192);
    cg::grid_group grid = cg::this_grid();
    volatile LAS unsigned* bst = (volatile LAS unsigned*)((LAS unsigned char*)ldsb + (LDS_BYTES - 64));
    if (threadIdx.x < 16) bst[threadIdx.x] = 0u;
    __syncthreads();
    XcdBarrier xbar; { const Params p0 = get_params(wbase_); xbar = xcd_barrier_post((unsigned*)(p0.ws + O_CNT + 16384), bst); }
    grid.sync();
#define RUN_PHASE(N, BODY) do { if constexpr (LO <= (N) && (N) < HI) { if ((N) > LO) xcd_barrier(xbar); const Params p = get_params(wbase_); BODY; } } while (0)
    RUN_PHASE(0, ph_prologue(p, ldsb));
    RUN_PHASE(1, ph_proj(p, ldsb));
    RUN_PHASE(2, { ph_cmp1(p, ldsb); __syncthreads(); ph_cmp2(p, ldsb); __syncthreads(); if (wbase_ >= 256) __builtin_amdgcn_s_setprio(1); ph_dilated2(p, ldsb); __builtin_amdgcn_s_setprio(0); });
    RUN_PHASE(4, { ph_combine(p); if (wbase_ >= 256) __builtin_amdgcn_s_setprio(1); ph_nsa2(p, ldsb); __builtin_amdgcn_s_setprio(0); });
    RUN_PHASE(5, ph_merge(p, ldsb));
    RUN_PHASE(6, ph_wout(p, ldsb));
    RUN_PHASE(7, { if (opq_bid() & 1) { moe_weight_convert_range(p, ldsb, CONV_EARLY, NEXP * (16 * 16 + 8 * 16), opq_bid() * NWAVES + (opq_tid(p.wbase) >> 6), opq_grid() * NWAVES); __syncthreads(); ph_ln1_route2(p, ldsb); }
                   else { ph_ln1_route2(p, ldsb); __syncthreads(); moe_weight_convert_range(p, ldsb, CONV_EARLY, NEXP * (16 * 16 + 8 * 16), opq_bid() * NWAVES + (opq_tid(p.wbase) >> 6), opq_grid() * NWAVES); } });
    RUN_PHASE(8, ph_moe_up(p, ldsb));
    RUN_PHASE(9, ph_moe_down(p, ldsb));
    RUN_PHASE(10, ph_final2(p));
}

template <int N> static void launch_phase(const Params& p, int grid_blocks, hipStream_t stream) {
    hipLaunchKernelGGL((mega<N, N + 1>), dim3(grid_blocks), dim3(NTHREADS), 0, stream, p);
}

extern "C" void kernel_launch(void* const* d_in, const int* in_sizes, int n_in, void* d_out, int out_size, void* d_ws, size_t ws_size, hipStream_t stream) {
    if (n_in != 21 || ws_size < WS_NEED || out_size != T * D) { fprintf(stderr, "kernel_launch: unexpected shapes n_in=%d ws=%zu out=%d\n", n_in, ws_size, out_size); return; }
    static int grid_blocks = 0;
    if (!grid_blocks) {
        int dev = 0, cus = 0;
        (void)hipGetDevice(&dev);
        (void)hipDeviceGetAttribute(&cus, hipDeviceAttributeMultiprocessorCount, dev);
        grid_blocks = cus;
#if ONE_LAUNCH
        int per_cu = 0;
        (void)hipOccupancyMaxActiveBlocksPerMultiprocessor(&per_cu, mega<0, NPHASE>, NTHREADS, 0);
        fprintf(stderr, "kernel_launch: cus=%d per_cu=%d grid=%d\n", cus, per_cu, grid_blocks);
#endif
    }
    Params p{};
    const float** pp = (const float**)&p;
    for (int i = 0; i < 21; ++i) pp[i] = (const float*)d_in[i];
    p.out = (float*)d_out; p.ws = (unsigned char*)d_ws;
    (void)hipMemsetAsync((unsigned char*)d_ws + O_CNT, 0, 32768, stream);
#if ONE_LAUNCH
    void* args[] = {&p};
    hipError_t e = hipLaunchCooperativeKernel((void*)mega<0, NPHASE>, dim3(grid_blocks), dim3(NTHREADS), args, 0, stream);
    if (e != hipSuccess) fprintf(stderr, "cooperative launch failed: %s (grid %d)\n", hipGetErrorString(e), grid_blocks);
#else
    launch_phase<0>(p, grid_blocks, stream); launch_phase<1>(p, grid_blocks, stream); launch_phase<2>(p, grid_blocks, stream); launch_phase<3>(p, grid_blocks, stream);
    launch_phase<4>(p, grid_blocks, stream); launch_phase<5>(p, grid_blocks, stream); launch_phase<6>(p, grid_blocks, stream); launch_phase<7>(p, grid_blocks, stream);
    launch_phase<8>(p, grid_blocks, stream); launch_phase<9>(p, grid_blocks, stream); launch_phase<10>(p, grid_blocks, stream);
#endif
}
```

```cpp
#include <hip/hip_runtime.h>
#include <hip/hip_cooperative_groups.h>
#include <cstdio>
#include <cstdint>
namespace cg = cooperative_groups;

#ifndef ONE_LAUNCH
#define ONE_LAUNCH 1
#endif

typedef unsigned short bf16_t;

constexpr int NB = 4, S = 8192, T = NB * S, D = 1024;
constexpr int INC = 5656;
constexpr int C_BQ = 2304, C_BKV = 2816, C_BG = 3584, C_MG = 3608;
constexpr int NEXP = 32, DEXP = 512;
constexpr float ALPHA = 1.189207115002721f;
constexpr float LN_EPS = 1e-5f;
constexpr float TINY = 1e-30f;
constexpr int NTHREADS = 512, NWAVES = 8;

constexpr size_t MiB = (size_t)1 << 20;
constexpr size_t KiB = 1024;
constexpr size_t O_WINT = 0;
constexpr size_t O_WBAT = 12 * MiB;
constexpr size_t O_WBBT = 12 * MiB + 512 * KiB;
constexpr size_t O_WOUTT = 13 * MiB + 512 * KiB;
constexpr size_t O_WC1KT = 15 * MiB + 512 * KiB;
constexpr size_t O_WC1VT = 16 * MiB + 512 * KiB;
constexpr size_t O_XB = 18 * MiB;
constexpr size_t O_H1B = 18 * MiB;
constexpr size_t O_OG = 18 * MiB;
constexpr size_t O_LSE = 66 * MiB;
constexpr size_t O_MG = 82 * MiB;
constexpr size_t O_WGUT = 82 * MiB;
constexpr size_t O_WDT = 146 * MiB;
constexpr size_t O_QA = 210 * MiB;
constexpr size_t O_KA = 258 * MiB;
constexpr size_t O_VAT = 306 * MiB;
constexpr size_t O_YB = 210 * MiB;
constexpr size_t O_YAB = 306 * MiB;
constexpr size_t O_MERGED = 242 * MiB;
constexpr size_t O_YE = 210 * MiB;
constexpr size_t O_XG = 210 * MiB;
constexpr size_t O_BQ = 354 * MiB;
constexpr size_t O_ACT = 354 * MiB;
constexpr size_t O_CK = 386 * MiB;
constexpr size_t O_CV = 394 * MiB;
constexpr size_t O_SK = 402 * MiB;
constexpr size_t O_SVT = 410 * MiB;
constexpr size_t O_WK = 418 * MiB;
constexpr size_t O_WVT = 426 * MiB;
constexpr size_t O_BG = 434 * MiB;
constexpr size_t O_KC = 437 * MiB;
constexpr size_t O_VCT = 437 * MiB + 512 * KiB;
constexpr size_t O_YA = 438 * MiB;
constexpr size_t O_HID = 454 * MiB;
constexpr size_t O_LIST = 462 * MiB;
constexpr size_t O_WTS = 466 * MiB;
constexpr size_t O_CNT = 467 * MiB;
constexpr size_t O_WC2T = 17 * MiB + 512 * KiB;
constexpr size_t O_WRT = 17 * MiB + 768 * KiB;
constexpr size_t O_CB = 17 * MiB + 1000 * KiB;
constexpr size_t O_H1L = 210 * MiB;
constexpr size_t O_ES = 468 * MiB;
constexpr size_t WS_NEED = 469 * MiB;
constexpr int PMAX = 2 * T + NEXP * 255;
static_assert(O_WINT + (size_t)5888 * 1024 * 2 <= O_WBAT && O_WBAT + 1024 * 256 * 2 <= O_WBBT && O_WBBT + 1024 * 512 * 2 <= O_WOUTT && O_WOUTT + 1024 * 1024 * 2 <= O_WC1KT &&
              O_WC1KT + 256 * 2048 * 2 <= O_WC1VT && O_WC1VT + 256 * 2048 * 2 <= O_XB && O_XB + (size_t)T * 1024 * 2 <= O_MG && O_MG + (size_t)T * 2048 * 2 <= O_QA &&
              O_VAT + 48 * MiB <= O_BQ && O_BQ + 32 * MiB <= O_CK && O_WVT + 8 * MiB <= O_BG && O_BG + (size_t)T * 24 * 4 <= O_KC && O_VCT + 512 * KiB <= O_YA && O_YA + 16 * MiB <= O_HID &&
              O_HID + 8 * MiB <= O_LIST && O_LIST + 4 * MiB <= O_WTS && O_WTS + (size_t)2 * T * 4 <= O_CNT, "ws map");
constexpr int NPAD_IN = 5888;
constexpr int LDS_BYTES = 163840;

struct Params {
    const float *x, *w_in, *cmp_pos_k, *cmp_w1_k, *cmp_w2_k, *cmp_pos_v, *cmp_w1_v, *cmp_w2_v, *w_br_a, *w_br_b, *w_out,
        *ln1_g, *ln1_b, *w_coarse, *b_coarse, *w_fine, *b_fine, *w_gate_up, *w_down, *ln2_g, *ln2_b;
    float* out;
    unsigned char* ws;
    int wbase, pad_;
};

__device__ __forceinline__ Params get_params(int wbase) {
    const volatile unsigned long long* kp = (const volatile unsigned long long*)__builtin_amdgcn_kernarg_segment_ptr();
    Params q; unsigned long long* qd = (unsigned long long*)&q;
#pragma unroll
    for (int k = 0; k < 23; ++k) { const unsigned long long v = kp[k]; qd[k] = ((unsigned long long)(unsigned)__builtin_amdgcn_readfirstlane((int)(v >> 32)) << 32) | (unsigned)__builtin_amdgcn_readfirstlane((int)v); }
    q.wbase = wbase; q.pad_ = 0;
    return q;
}
__device__ __forceinline__ int opq_tid(int wbase) { int t; asm volatile("v_mbcnt_lo_u32_b32 %0, -1, 0\n\tv_mbcnt_hi_u32_b32 %0, -1, %0" : "=v"(t)); return wbase + t; }
__device__ __forceinline__ int opq_bid() { int b = blockIdx.x; asm volatile("" : "+s"(b)); return b; }
__device__ __forceinline__ int opq_grid() { int b = gridDim.x; asm volatile("" : "+s"(b)); return b; }
__device__ __forceinline__ float bf2f(bf16_t v) { return __uint_as_float(((unsigned)v) << 16); }
__device__ __forceinline__ bf16_t f2bf(float f) { unsigned u = __float_as_uint(f); return (bf16_t)((u + 0x7fffu + ((u >> 16) & 1u)) >> 16); }
__device__ __forceinline__ float ldf(const float* p) { return *p; }
__device__ __forceinline__ float ldf(const bf16_t* p) { return bf2f(*p); }
__device__ __forceinline__ float sigmoid_(float v) { return 1.f / (1.f + expf(-v)); }
__device__ __forceinline__ float wave_sum(float v) {
#pragma unroll
    for (int o = 1; o < 64; o <<= 1) v += __shfl_xor(v, o);
    return v;
}
__device__ __forceinline__ float wave_max(float v) {
#pragma unroll
    for (int o = 1; o < 64; o <<= 1) v = fmaxf(v, __shfl_xor(v, o));
    return v;
}
template <int N> __device__ __forceinline__ void tr_step(float (&v)[64], int lane) {
    constexpr int H = N / 2;
    const bool up = (lane & H) != 0;
#pragma unroll
    for (int i = 0; i < H; ++i) {
        const float keep = up ? v[i + H] : v[i];
        const float send = up ? v[i] : v[i + H];
        v[i] = keep + __shfl_xor(send, H);
    }
}
template <int N> __device__ __forceinline__ void tr_step32(float (&v)[32], int lane) {
    constexpr int H = N / 2;
    const bool up = (lane & H) != 0;
#pragma unroll
    for (int i = 0; i < H; ++i) {
        const float keep = up ? v[i + H] : v[i];
        const float send = up ? v[i] : v[i + H];
        v[i] = keep + __shfl_xor(send, H);
    }
}
__device__ __forceinline__ float tr_reduce32(float (&v)[32], int lane) {
    tr_step32<32>(v, lane); tr_step32<16>(v, lane); tr_step32<8>(v, lane); tr_step32<4>(v, lane); tr_step32<2>(v, lane);
    return v[0] + __shfl_xor(v[0], 32);
}
__device__ __forceinline__ float tr_reduce64(float (&v)[64], int lane) {
    tr_step<64>(v, lane); tr_step<32>(v, lane); tr_step<16>(v, lane); tr_step<8>(v, lane); tr_step<4>(v, lane); tr_step<2>(v, lane);
    return v[0];
}

__device__ __forceinline__ float dot64(const float* q, const bf16_t* kr) {
    float s = 0.f;
#pragma unroll
    for (int c = 0; c < 8; ++c) {
        const uint4 u = *(const uint4*)(kr + c * 8);
        const float4 qa = *(const float4*)(q + c * 8), qb = *(const float4*)(q + c * 8 + 4);
        s += qa.x * __uint_as_float(u.x << 16) + qa.y * __uint_as_float(u.x & 0xffff0000u);
        s += qa.z * __uint_as_float(u.y << 16) + qa.w * __uint_as_float(u.y & 0xffff0000u);
        s += qb.x * __uint_as_float(u.z << 16) + qb.y * __uint_as_float(u.z & 0xffff0000u);
        s += qb.z * __uint_as_float(u.w << 16) + qb.w * __uint_as_float(u.w & 0xffff0000u);
    }
    return s;
}
__device__ __forceinline__ int dil_of(int g) { return g == 0 ? 1 : (g == 1 ? 4 : 16); }

__device__ __forceinline__ void store_u(const Params& p, int t, int c, float v) {
    unsigned char* ws = p.ws;
    const int b = t / S, s = t % S;
    if (c < C_BQ) {
        const int which = c / 768, cc = c % 768, g = cc / 256, h = (cc % 256) / 64, e = cc % 64;
        const int d = dil_of(g), L = S / d, ps = (s % d) * L + s / d;
        const size_t base = (size_t)((b * 3 + g) * 4 + h);
        if (which == 0) ((bf16_t*)(ws + O_QA))[(base * S + ps) * 64 + e] = f2bf(v);
        else if (which == 1) ((bf16_t*)(ws + O_KA))[(base * S + ps) * 64 + e] = f2bf(v);
        else ((bf16_t*)(ws + O_VAT))[(base * 64 + e) * S + ps] = f2bf(v);
    } else if (c < C_BKV) {
        ((bf16_t*)(ws + O_BQ))[(size_t)t * 512 + (c - C_BQ)] = f2bf(v);
    } else if (c < C_BG) {
        const int cc = c - C_BKV, i = cc / 128, g = (cc % 128) / 64, e = cc % 64;
        const size_t bg = (size_t)(b * 2 + g);
        const bf16_t bv = f2bf(v);
        if (i == 0) ((bf16_t*)(ws + O_CK))[(bg * S + s) * 64 + e] = bv;
        else if (i == 1) ((bf16_t*)(ws + O_CV))[(bg * S + s) * 64 + e] = bv;
        else if (i == 2) ((bf16_t*)(ws + O_SK))[(bg * S + s) * 64 + e] = bv;
        else if (i == 3) ((bf16_t*)(ws + O_SVT))[(bg * 64 + e) * S + s] = bv;
        else if (i == 4) ((bf16_t*)(ws + O_WK))[(bg * S + s) * 64 + e] = bv;
        else ((bf16_t*)(ws + O_WVT))[(bg * 64 + e) * S + s] = bv;
    } else if (c < C_MG) {
        ((float*)(ws + O_BG))[(size_t)t * 24 + (c - C_BG)] = sigmoid_(v);
    } else {
        ((bf16_t*)(ws + O_MG))[(size_t)t * 2048 + (c - C_MG)] = f2bf(sigmoid_(v));
    }
}

template <typename TA, typename TB>
__device__ __forceinline__ void sgemm_tile(float (&acc)[4][8], const TA* arow, const float* aadd, const TB* Bp, int ldb, int ncv, int K, float* lds, int tid) {
    float* As = lds; float* Bs = lds + 16 * 132;
    const int tx = tid & 15, ty = tid >> 4;
    const int ar = tid >> 2, ak = (tid & 3) * 4;
    const int bk = tid >> 5, bc = (tid & 31) * 4;
#pragma unroll 1
    for (int k0 = 0; k0 < K; k0 += 16) {
        float av[4], bv[4];
#pragma unroll
        for (int j = 0; j < 4; ++j) {
            av[j] = arow ? ldf(arow + k0 + ak + j) : 0.f;
            if (aadd) av[j] += aadd[k0 + ak + j];
            bv[j] = (bc + j < ncv) ? ldf(Bp + (size_t)(k0 + bk) * ldb + bc + j) : 0.f;
        }
        __syncthreads();
#pragma unroll
        for (int j = 0; j < 4; ++j) { As[(ak + j) * 132 + ar] = av[j]; Bs[bk * 128 + bc + j] = bv[j]; }
        __syncthreads();
#pragma unroll
        for (int kk = 0; kk < 16; ++kk) {
            float a[4], b[8];
#pragma unroll
            for (int i = 0; i < 4; ++i) a[i] = As[kk * 132 + ty * 4 + i];
#pragma unroll
            for (int j = 0; j < 8; ++j) b[j] = Bs[kk * 128 + tx * 8 + j];
#pragma unroll
            for (int i = 0; i < 4; ++i)
#pragma unroll
                for (int j = 0; j < 8; ++j) acc[i][j] += a[i] * b[j];
            if ((kk & 3) == 3) asm volatile("" ::: "memory");
        }
    }
    __syncthreads();
}
__device__ __forceinline__ void zero_acc(float (&acc)[4][8]) {
#pragma unroll
    for (int i = 0; i < 4; ++i)
#pragma unroll
        for (int j = 0; j < 8; ++j) acc[i][j] = 0.f;
}

template <class KF>
__device__ __forceinline__ void attend_naive(const float* q, int nkeys, int vstride, KF kf, int lane, float& o_out, float& lse_out) {
    float m = -INFINITY;
    for (int i0 = 0; i0 < nkeys; i0 += 64) {
        const int i = i0 + lane;
        const bf16_t* kr = nullptr; const bf16_t* vc = nullptr; float bias = 0.f;
        const bool valid = (i < nkeys) && kf(i, kr, vc, bias);
        if (valid) {
            float s = dot64(q, kr);
            s = s * 0.125f + bias;
            m = fmaxf(m, s);
        }
    }
    m = wave_max(m);
    if (!(m > -INFINITY)) m = 0.f;
    float l = 0.f, ohalf[2];
#pragma unroll 1
    for (int half = 0; half < 2; ++half) {
        float op[32];
#pragma unroll
        for (int d = 0; d < 32; ++d) op[d] = 0.f;
        l = 0.f;
        for (int i0 = 0; i0 < nkeys; i0 += 64) {
            const int i = i0 + lane;
            const bf16_t* kr = nullptr; const bf16_t* vc = nullptr; float bias = 0.f;
            const bool valid = (i < nkeys) && kf(i, kr, vc, bias);
            if (valid) {
                float s = dot64(q, kr);
                s = s * 0.125f + bias;
                const float pe = expf(s - m);
                l += pe;
                const bf16_t* vh = vc + (size_t)(half * 32) * vstride;
#pragma unroll
                for (int d = 0; d < 32; ++d) op[d] += pe * bf2f(vh[(size_t)d * vstride]);
            }
        }
        const float r = tr_reduce32(op, lane);
        if (half == 0) ohalf[0] = r; else ohalf[1] = r;
    }
    l = wave_sum(l);
    const float o = lane < 32 ? ohalf[0] : ohalf[1];
    o_out = o / fmaxf(l, TINY);
    lse_out = m + logf(l);
}

namespace pg8 {
#define PG8_LAS __attribute__((address_space(3)))
typedef unsigned short bf16_t;
typedef short bf16x8 __attribute__((ext_vector_type(8)));
typedef float f32x4 __attribute__((ext_vector_type(4)));
typedef unsigned u32x4 __attribute__((ext_vector_type(4)));
constexpr int BM = 256, BK = 64, HALF = 128, HTB = HALF * BK * 2  , STAGE_BYTES = 8 * HTB, NXCD = 8, WGM = 8;

__host__ __device__ __forceinline__ int lds_byte(int r, int c) { const int st = (r >> 4) * 2 + (c >> 5), rr = r & 15, cc = c & 31, ob = rr * 64 + cc * 2; return st * 1024 + (ob ^ (((ob >> 9) & 1) << 5)); }
__host__ __device__ __forceinline__ void stage_rc(int b, int& R, int& C) { const int st = b / 1024, sb = b % 1024, swz = sb ^ (((sb >> 9) & 1) << 5); R = (st >> 1) * 16 + swz / 64; C = (st & 1) * 32 + (swz % 64) / 2; }
__host__ __device__ __forceinline__ int perm32(int rho) { const int n = rho >> 4, i = rho & 15; return 8 * (i >> 2) + 4 * n + (i & 3); }


struct Unit { int pm, pn; const char* a; const char* b; const int* rows; int nrows; };
struct Gemm { int K, lda, wbase; };
__device__ __forceinline__ const char* uni_ptr(const char* p) { const unsigned long long v = (unsigned long long)p; const unsigned lo = (unsigned)__builtin_amdgcn_readfirstlane((int)(unsigned)v), hi = (unsigned)__builtin_amdgcn_readfirstlane((int)(unsigned)(v >> 32)); return (const char*)(((unsigned long long)hi << 32) | lo); }
typedef float f32x2_t __attribute__((ext_vector_type(2))); typedef __bf16 bf16x2_t __attribute__((ext_vector_type(2)));
__device__ __forceinline__ unsigned cvt_pk_bf16(float lo, float hi) { f32x2_t v = {lo, hi}; bf16x2_t b = __builtin_convertvector(v, bf16x2_t); return __builtin_bit_cast(unsigned, b); }
template <class Epi, class Sched, bool ALIGN_EPI = false, bool SP2 = false, bool GATHER = false>
__device__ __forceinline__ void gemm_phase(PG8_LAS unsigned char* lds, const Gemm g, const Sched& S, const Epi& E) {
    const int tid = opq_tid(g.wbase), wid = __builtin_amdgcn_readfirstlane(tid >> 6), lane = tid & 63, wr = wid >> 2, wc = wid & 3, fr = lane & 15, fq = lane >> 4;
    int Kq = g.K; asm volatile("" : "+s"(Kq));
    const int K = Kq, nt = K / BK;
    unsigned voffA[2], voffB[2];
#pragma unroll
    for (int i = 0; i < 2; ++i) { int R, C; stage_rc(tid * 16 + i * 8192, R, C); const int Rb = Epi::PERM ? ((R & ~31) + perm32(R & 31)) : R;
        voffA[i] = (unsigned)(R * g.lda + C) * 2u; voffB[i] = (unsigned)(Rb * K + C) * 2u; }
    const size_t kstep = (size_t)(BK * 2);
    const size_t hstepA = (size_t)HALF * g.lda * 2, hstepB = (size_t)HALF * K * 2;
    const unsigned ldsw = (unsigned)wid * 1024u;
    const int aoff = lds_byte(wr * 64 + fr, fq * 8), boff = lds_byte(wc * 32 + fr, fq * 8);
#define PG8_SA(b, h) (((b) * 2 + (h)) * HTB)
#define PG8_SB(b, h) ((4 + (b) * 2 + (h)) * HTB)
#define PG8_STAGE(bufoff, gbase, voff) do { _Pragma("unroll") for (int _i = 0; _i < 2; ++_i) \
        __builtin_amdgcn_global_load_lds((const unsigned*)((const char*)(gbase) + (voff)[_i]), (PG8_LAS unsigned*)(lds + (bufoff) + ldsw + _i * 8192), 16, 0, 0); } while (0)
#define PG8_STAGE_A(b_, h_, ptr_, nsel_) do { if constexpr (GATHER) { const unsigned pk_ = (nsel_) ? nvg[h_] : cvg[h_]; unsigned vo_[2]; vo_[0] = (pk_ & 0xffffu) * (unsigned)(g.lda * 2) + gcol[0]; vo_[1] = (pk_ >> 16) * (unsigned)(g.lda * 2) + gcol[1]; PG8_STAGE(PG8_SA(b_, h_), ptr_, vo_); } \
        else { PG8_STAGE(PG8_SA(b_, h_), (ptr_) + (h_) * hstepA, voffA); } } while (0)
#define PG8_LDA(dst, b, h) do { _Pragma("unroll") for (int m = 0; m < 4; ++m) _Pragma("unroll") for (int k = 0; k < 2; ++k) dst[m][k] = *(const PG8_LAS bf16x8*)(lds + PG8_SA(b, h) + aoff + m * 2048 + k * 1024); } while (0)
#define PG8_LDB(dst, b, h) do { _Pragma("unroll") for (int n = 0; n < 2; ++n) _Pragma("unroll") for (int k = 0; k < 2; ++k) dst[n][k] = *(const PG8_LAS bf16x8*)(lds + PG8_SB(b, h) + boff + n * 2048 + k * 1024); } while (0)
#define PG8_MMA(ai, bj, At, Bt) do { __builtin_amdgcn_s_setprio(1); _Pragma("unroll") for (int m = 0; m < 4; ++m) _Pragma("unroll") for (int n = 0; n < 2; ++n) _Pragma("unroll") for (int k = 0; k < 2; ++k) \
        acc[ai][bj][m][n] = __builtin_amdgcn_mfma_f32_16x16x32_bf16(Bt[n][k], At[m][k], acc[ai][bj][m][n], 0, 0, 0); __builtin_amdgcn_s_setprio(0); } while (0)
#define PG8_WAIT_V(n) asm volatile("s_waitcnt vmcnt(" #n ")" ::: "memory")
#define PG8_WAIT_L(n) asm volatile("s_waitcnt lgkmcnt(" #n ")" ::: "memory")
#define PG8_BAR __builtin_amdgcn_s_barrier()
#define PG8_SCHED __builtin_amdgcn_sched_barrier(0)
    Unit cur, nxt; int ui = 0;
    if (!S.next(0, cur)) return;
    unsigned gcol[2]; { int R_, C_; stage_rc(tid * 16, R_, C_); gcol[0] = (unsigned)C_ * 2u; stage_rc(tid * 16 + 8192, R_, C_); gcol[1] = (unsigned)C_ * 2u; }
    unsigned cvg[2] = {0u, 0u}, nvg[2] = {0u, 0u};
    auto calc_vg = [&](const Unit& u_, unsigned (&vg_)[2]) {
#pragma unroll
        for (int h_ = 0; h_ < 2; ++h_) {
            unsigned pk_ = 0u;
#pragma unroll
            for (int i_ = 0; i_ < 2; ++i_) { int R_, C_; stage_rc(tid * 16 + i_ * 8192, R_, C_); const int idx_ = h_ * HALF + R_; const unsigned tok_ = idx_ < u_.nrows ? (unsigned)(u_.rows[idx_] >> 1) : 0u; pk_ |= tok_ << (16 * i_); }
            vg_[h_] = pk_;
        }
    };
    if constexpr (GATHER) calc_vg(cur, cvg);
    f32x4 acc[2][2][4][2];
#pragma unroll
    for (int a = 0; a < 2; ++a)
#pragma unroll
        for (int b = 0; b < 2; ++b)
#pragma unroll
            for (int m = 0; m < 4; ++m)
#pragma unroll
                for (int n = 0; n < 2; ++n) acc[a][b][m][n] = (f32x4){0.f, 0.f, 0.f, 0.f};
    bf16x8 At[4][2], B0[2][2], B1[2][2];
    const char* cA = uni_ptr(cur.a); const char* cB = uni_ptr(cur.b);
    S.a_ready(cur);
    if constexpr (SP2) {
        PG8_STAGE(PG8_SB(0, 0), cB, voffB); PG8_STAGE(PG8_SB(0, 1), cB + hstepB, voffB); PG8_STAGE_A(0, 0, cA, false); PG8_STAGE_A(0, 1, cA, false);
        if (wr == 1) PG8_BAR;
        PG8_WAIT_V(2); PG8_BAR;
        PG8_STAGE(PG8_SB(1, 0), cB + kstep, voffB); PG8_STAGE_A(1, 0, cA + kstep, false); PG8_STAGE(PG8_SB(1, 1), cB + hstepB + kstep, voffB);
        PG8_WAIT_V(6); PG8_BAR;
    } else {
        PG8_STAGE(PG8_SB(0, 0), cB, voffB); PG8_STAGE_A(0, 0, cA, false); PG8_STAGE(PG8_SB(0, 1), cB + hstepB, voffB); PG8_STAGE_A(0, 1, cA, false);
        if (wr == 1) PG8_BAR;
        PG8_WAIT_V(4); PG8_BAR;
        PG8_STAGE(PG8_SB(1, 0), cB + kstep, voffB); PG8_STAGE_A(1, 0, cA + kstep, false); PG8_STAGE(PG8_SB(1, 1), cB + hstepB + kstep, voffB);
        PG8_WAIT_V(6); PG8_BAR;
    }
    for (;;) {
        const bool has_next = S.next(ui + 1, nxt);
        const char* nA = uni_ptr(has_next ? nxt.a : cA); const char* nB = uni_ptr(has_next ? nxt.b : cB);
        if constexpr (GATHER) { if (has_next) calc_vg(nxt, nvg); else { nvg[0] = cvg[0]; nvg[1] = cvg[1]; } }
        for (int t = 0; t < nt; t += 2) {
            const bool last = (t == nt - 2);
            const char* a1 = cA + (size_t)(t + 1) * kstep;
            const char* a2 = last ? nA : cA + (size_t)(t + 2) * kstep; const char* b2 = last ? nB : cB + (size_t)(t + 2) * kstep;
            const char* a3 = a2 + kstep; const char* b3 = b2 + kstep;
            if (last && has_next) S.a_ready(nxt);
            if constexpr (Epi::MID_T > 0) { if (t == Epi::MID_T) E.mid(acc, cur, wr, wc, fr, fq); }
            if constexpr (SP2) {
            PG8_LDB(B0, 0, 0); PG8_LDB(B1, 0, 1); PG8_SCHED; PG8_LDA(At, 0, 0); PG8_STAGE_A(1, 1, a1, false);
            PG8_WAIT_V(8); PG8_WAIT_L(0); PG8_BAR; PG8_MMA(0, 0, At, B0); PG8_MMA(0, 1, At, B1); PG8_BAR; PG8_SCHED;
            PG8_LDA(At, 0, 1); PG8_STAGE(PG8_SB(0, 0), b2, voffB); PG8_STAGE(PG8_SB(0, 1), b2 + hstepB, voffB); PG8_STAGE_A(0, 0, a2, last);
            PG8_WAIT_V(8); PG8_WAIT_L(0); PG8_BAR; PG8_MMA(1, 0, At, B0); PG8_MMA(1, 1, At, B1); PG8_BAR; PG8_SCHED;
            PG8_LDB(B0, 1, 0); PG8_LDB(B1, 1, 1); PG8_SCHED; PG8_LDA(At, 1, 0); PG8_STAGE_A(0, 1, a2, last);
            PG8_WAIT_V(8); PG8_WAIT_L(0); PG8_BAR; PG8_MMA(0, 0, At, B0); PG8_MMA(0, 1, At, B1); PG8_BAR; PG8_SCHED;
            PG8_LDA(At, 1, 1); PG8_STAGE(PG8_SB(1, 0), b3, voffB); PG8_STAGE(PG8_SB(1, 1), b3 + hstepB, voffB); PG8_STAGE_A(1, 0, a3, last);
            PG8_WAIT_V(8); PG8_WAIT_L(0); PG8_BAR; PG8_MMA(1, 0, At, B0); PG8_MMA(1, 1, At, B1); PG8_BAR; PG8_SCHED;
            } else {
            PG8_LDB(B0, 0, 0); PG8_SCHED; PG8_LDA(At, 0, 0); PG8_STAGE_A(1, 1, a1, false);
            PG8_WAIT_L(8); PG8_BAR; PG8_WAIT_L(0); PG8_MMA(0, 0, At, B0); PG8_BAR; PG8_SCHED;
            PG8_LDB(B1, 0, 1); PG8_STAGE(PG8_SB(0, 0), b2, voffB);
            PG8_BAR; PG8_WAIT_L(0); PG8_MMA(0, 1, At, B1); PG8_BAR;
            PG8_LDA(At, 0, 1); PG8_STAGE_A(0, 0, a2, last);
            PG8_BAR; PG8_WAIT_L(0); PG8_MMA(1, 0, At, B0); PG8_BAR; PG8_SCHED;
            PG8_STAGE(PG8_SB(0, 1), b2 + hstepB, voffB);
            PG8_WAIT_V(6); PG8_BAR; PG8_MMA(1, 1, At, B1); PG8_BAR;
            PG8_LDB(B0, 1, 0); PG8_SCHED; PG8_LDA(At, 1, 0); PG8_STAGE_A(0, 1, a2, last);
            PG8_WAIT_L(8); PG8_BAR; PG8_WAIT_L(0); PG8_MMA(0, 0, At, B0); PG8_BAR; PG8_SCHED;
            PG8_LDB(B1, 1, 1); PG8_STAGE(PG8_SB(1, 0), b3, voffB);
            PG8_BAR; PG8_WAIT_L(0); PG8_MMA(0, 1, At, B1); PG8_BAR;
            PG8_LDA(At, 1, 1); PG8_STAGE_A(1, 0, a3, last);
            PG8_BAR; PG8_WAIT_L(0); PG8_MMA(1, 0, At, B0); PG8_BAR; PG8_SCHED;
            PG8_STAGE(PG8_SB(1, 1), b3 + hstepB, voffB);
            PG8_WAIT_V(6); PG8_BAR; PG8_MMA(1, 1, At, B1); PG8_BAR;
            }
        }
        if constexpr (ALIGN_EPI) { if (wr == 0) PG8_BAR; }
        if constexpr (!Epi::AFTER_DRAIN) { E(acc, cur, wr, wc, fr, fq); S.done(cur); }
        if (!has_next) break;
#pragma unroll
        for (int a = 0; a < 2; ++a)
#pragma unroll
            for (int b = 0; b < 2; ++b)
#pragma unroll
                for (int m = 0; m < 4; ++m)
#pragma unroll
                    for (int n = 0; n < 2; ++n) acc[a][b][m][n] = (f32x4){0.f, 0.f, 0.f, 0.f};
        cur = nxt; cA = nA; cB = nB; ++ui;
        if constexpr (GATHER) { cvg[0] = nvg[0]; cvg[1] = nvg[1]; }
        if constexpr (ALIGN_EPI) { if (wr == 1) PG8_BAR; }
    }
    PG8_WAIT_V(0);
    if constexpr (!ALIGN_EPI) { if (wr == 0) PG8_BAR; }
    PG8_BAR;
    if constexpr (Epi::AFTER_DRAIN) { E.fused(acc, cur, wr, wc, fr, fq, lds, wid, lane); S.done(cur); }
#undef PG8_SA
#undef PG8_SB
#undef PG8_STAGE
#undef PG8_STAGE_A
#undef PG8_LDA
#undef PG8_LDB
#undef PG8_MMA
#undef PG8_WAIT_V
#undef PG8_WAIT_L
#undef PG8_BAR
#undef PG8_SCHED
}
}

#define LAS __attribute__((address_space(3)))
typedef unsigned v4u __attribute__((ext_vector_type(4)));
typedef float f32x4 __attribute__((ext_vector_type(4)));

struct TileOrder {
    int nM, nN, nwg, G, c; const char* A; const char* Bt; size_t tstepA, tstepB;
    __device__ __forceinline__ void init(const void* A_, const void* Bt_, int M, int N, int K, int lda, int G_, int c_) {
        nM = M / 256; nN = N / 256; nwg = nM * nN; G = G_; c = c_; A = (const char*)A_; Bt = (const char*)Bt_; tstepA = (size_t)256 * lda * 2; tstepB = (size_t)256 * K * 2; }
    __device__ __forceinline__ bool next(int i, pg8::Unit& u) const {
        const long L = (long)i * G + c; if (L >= nwg) return false;
        int wgid = (int)L; { const int q = nwg / 8, r = nwg % 8, xcd = wgid % 8, off = wgid / 8; wgid = (xcd < r ? xcd * (q + 1) : r * (q + 1) + (xcd - r) * q) + off; }
        const int nig = 8 * nN, gid = wgid / nig, fm = gid * 8, gsz = (nM - fm) < 8 ? (nM - fm) : 8;
        u.pm = fm + ((wgid % nig) % gsz); u.pn = (wgid % nig) / gsz; u.a = A + (size_t)u.pm * tstepA; u.b = Bt + (size_t)u.pn * tstepB; u.rows = nullptr; u.nrows = 0; return true;
    }
    __device__ __forceinline__ void a_ready(const pg8::Unit&) const {}
    __device__ __forceinline__ void done(const pg8::Unit&) const {}
};

constexpr float QK_C0 = 0.125f * 1.4426950408889634f;
__device__ __forceinline__ float fsigmoid(float v) { return __builtin_amdgcn_rcpf(1.f + __expf(-v)); }
__device__ __forceinline__ void store_u8(unsigned char* ws, int t, int c0, const f32x4 v0, const f32x4 v1) {
    if (c0 >= INC) return;
    const int b = t >> 13, s = t & (S - 1);
    if (c0 >= C_BG + 2048) c0 -= 2048;
    if (c0 >= C_BG) {
        float* o = (float*)(ws + O_BG) + (size_t)t * 24 + (c0 - C_BG);
        *(f32x4*)o = (f32x4){fsigmoid(v0[0]), fsigmoid(v0[1]), fsigmoid(v0[2]), fsigmoid(v0[3])};
        *(f32x4*)(o + 4) = (f32x4){fsigmoid(v1[0]), fsigmoid(v1[1]), fsigmoid(v1[2]), fsigmoid(v1[3])};
        return;
    }
    const float qs = (c0 < 768 || (c0 >= C_BQ && c0 < C_BKV)) ? QK_C0 : 1.f;
    v4u w; w.x = pg8::cvt_pk_bf16(v0[0] * qs, v0[1] * qs); w.y = pg8::cvt_pk_bf16(v0[2] * qs, v0[3] * qs); w.z = pg8::cvt_pk_bf16(v1[0] * qs, v1[1] * qs); w.w = pg8::cvt_pk_bf16(v1[2] * qs, v1[3] * qs);
    bf16_t* tp = nullptr; bf16_t* rp = nullptr;
    if (c0 < C_BQ) {
        const int which = c0 / 768, cc = c0 - which * 768, g = cc >> 8, h = (cc >> 6) & 3, e0 = cc & 63, sh = 2 * g;
        const int ps = ((s & ((1 << sh) - 1)) << (13 - sh)) + (s >> sh);
        const size_t base = (size_t)((b * 3 + g) * 4 + h);
        if (which == 2) tp = (bf16_t*)(ws + O_VAT) + (base * 64 + e0) * S + ps;
        else rp = (bf16_t*)(ws + (which ? O_KA : O_QA)) + (base * S + ps) * 64 + e0;
    } else if (c0 < C_BKV) {
        rp = (bf16_t*)(ws + O_BQ) + (size_t)t * 512 + (c0 - C_BQ);
    } else {
        const int cc = c0 - C_BKV, i = cc >> 7, g = (cc >> 6) & 1, e0 = cc & 63; const size_t bg = (size_t)(b * 2 + g);
        bf16_t* buf = (bf16_t*)(ws + O_CK + (size_t)i * 8 * MiB);
        if (i == 3 || i == 5) tp = buf + (bg * 64 + e0) * S + s; else rp = buf + (bg * S + s) * 64 + e0;
    }
    if (rp) *(v4u*)rp = w;
    else {
        tp[0] = (bf16_t)(w.x & 0xffffu); tp[(size_t)S] = (bf16_t)(w.x >> 16); tp[(size_t)2 * S] = (bf16_t)(w.y & 0xffffu); tp[(size_t)3 * S] = (bf16_t)(w.y >> 16);
        tp[(size_t)4 * S] = (bf16_t)(w.z & 0xffffu); tp[(size_t)5 * S] = (bf16_t)(w.z >> 16); tp[(size_t)6 * S] = (bf16_t)(w.w & 0xffffu); tp[(size_t)7 * S] = (bf16_t)(w.w >> 16);
    }
}
__device__ __forceinline__ bool vspan(unsigned char* ws, int c0, int b, bf16_t*& dst, int& sh) {
    if (c0 >= 1536 && c0 < C_BQ) {
        const int cc = c0 - 1536, g = cc >> 8, h = (cc >> 6) & 3, e0 = cc & 63;
        dst = (bf16_t*)(ws + O_VAT) + ((size_t)((b * 3 + g) * 4 + h) * 64 + e0) * S; sh = 2 * g; return true;
    }
    if (c0 >= C_BKV && c0 < C_BG) {
        const int cc = c0 - C_BKV, i = cc >> 7, g = (cc >> 6) & 1, e0 = cc & 63;
        if (i == 3 || i == 5) { dst = (bf16_t*)(ws + O_CK + (size_t)i * 8 * MiB) + ((size_t)(b * 2 + g) * 64 + e0) * S; sh = 0; return true; }
    }
    return false;
}
struct EpiProj {
    static constexpr bool PERM = true, AFTER_DRAIN = false; static constexpr int MID_T = 0;
    unsigned char* ws_; unsigned char* lds_;
    __device__ __forceinline__ void operator()(const f32x4 (&acc)[2][2][4][2], const pg8::Unit& u, int wr, int wc, int fr, int fq) const {
        unsigned char* ws = ws_; asm volatile("" : "+s"(ws));
        const int lane = fq * 16 + fr;
        if (u.pn >= C_BG / 256 && u.pn < C_BG / 256 + 8) {
            bf16_t* MG = (bf16_t*)(ws + O_MG);
#pragma unroll
            for (int ai = 0; ai < 2; ++ai)
#pragma unroll
                for (int m = 0; m < 4; ++m) {
                    const int row = u.pm * 256 + ai * 128 + wr * 64 + m * 16 + fr, ch0 = (u.pn - C_BG / 256) * 128 + wc * 32 + 8 * fq;
                    float rr_[8], gb_[8];
#pragma unroll
                    for (int n = 0; n < 2; ++n)
#pragma unroll
                        for (int j = 0; j < 4; ++j) {
                            const float ga = fsigmoid(acc[ai][0][m][n][j]);
                            const float tinv = fminf(1.f + __expf(-acc[ai][1][m][n][j]), 1.0995116e12f);
                            rr_[4 * n + j] = ga * tinv; gb_[4 * n + j] = __builtin_amdgcn_rcpf(tinv);
                        }
                    v4u w0, w1;
                    w0.x = pg8::cvt_pk_bf16(rr_[0], rr_[1]); w0.y = pg8::cvt_pk_bf16(rr_[2], rr_[3]); w0.z = pg8::cvt_pk_bf16(rr_[4], rr_[5]); w0.w = pg8::cvt_pk_bf16(rr_[6], rr_[7]);
                    w1.x = pg8::cvt_pk_bf16(gb_[0], gb_[1]); w1.y = pg8::cvt_pk_bf16(gb_[2], gb_[3]); w1.z = pg8::cvt_pk_bf16(gb_[4], gb_[5]); w1.w = pg8::cvt_pk_bf16(gb_[6], gb_[7]);
                    *(v4u*)(MG + (size_t)row * 2048 + ch0) = w0; *(v4u*)(MG + (size_t)row * 2048 + 1024 + ch0) = w1;
                    asm volatile("" ::: "memory");
                }
            return;
        }
        bf16_t* stg = (bf16_t*)(lds_ + (wr * 4 + wc) * 2048);
#pragma unroll
        for (int ai = 0; ai < 2; ++ai) {
            const int row0 = u.pm * 256 + ai * 128 + wr * 64;
            const int b = row0 >> 13, s0 = row0 & (S - 1);
#pragma unroll
            for (int bj = 0; bj < 2; ++bj) {
                const int cs = u.pn * 256 + bj * 128 + wc * 32;
                bf16_t* vdst = nullptr; int sh = 0;
                if (vspan(ws, cs, b, vdst, sh)) {
                    const int d = 1 << sh, per = 64 >> sh;
#pragma unroll
                    for (int ps = 0; ps < 2; ++ps) {
                        if ((fq >> 1) == ps) {
#pragma unroll
                            for (int m = 0; m < 4; ++m) {
                                const int t = 16 * m + fr, rho = (t & (d - 1)) * per + (t >> sh);
                                bf16_t* wp = stg + (8 * (fq & 1)) * 64 + rho;
                                const f32x4 v0 = acc[ai][bj][m][0], v1 = acc[ai][bj][m][1];
                                const unsigned w0 = pg8::cvt_pk_bf16(v0[0], v0[1]), w1 = pg8::cvt_pk_bf16(v0[2], v0[3]), w2 = pg8::cvt_pk_bf16(v1[0], v1[1]), w3 = pg8::cvt_pk_bf16(v1[2], v1[3]);
                                wp[0] = (bf16_t)(w0 & 0xffffu); wp[64] = (bf16_t)(w0 >> 16); wp[128] = (bf16_t)(w1 & 0xffffu); wp[192] = (bf16_t)(w1 >> 16);
                                wp[256] = (bf16_t)(w2 & 0xffffu); wp[320] = (bf16_t)(w2 >> 16); wp[384] = (bf16_t)(w3 & 0xffffu); wp[448] = (bf16_t)(w3 >> 16);
                            }
                        }
                        asm volatile("s_waitcnt lgkmcnt(0)" ::: "memory");
#pragma unroll
                        for (int k = 0; k < 2; ++k) {
                            const int col = lane >> 2, ch = (lane & 3) + 4 * k, pos = 8 * ch;
                            const v4u val = *(const v4u*)(stg + col * 64 + pos);
                            bf16_t* drow = vdst + (size_t)(16 * ps + col) * S;
                            if (sh < 4) {
                                const int rc = pos / per, li = pos - rc * per;
                                *(v4u*)(drow + (size_t)rc * (S >> sh) + (s0 >> sh) + li) = val;
                            } else {
                                const int rc = pos >> 2;
                                *(uint2*)(drow + (size_t)rc * (S >> 4) + (s0 >> 4)) = make_uint2(val.x, val.y);
                                *(uint2*)(drow + (size_t)(rc + 1) * (S >> 4) + (s0 >> 4)) = make_uint2(val.z, val.w);
                            }
                        }
                        asm volatile("s_waitcnt lgkmcnt(0)" ::: "memory");
                    }
                } else {
#pragma unroll
                    for (int m = 0; m < 4; ++m) { store_u8(ws, row0 + m * 16 + fr, cs + 8 * fq, acc[ai][bj][m][0], acc[ai][bj][m][1]); asm volatile("" ::: "memory"); }
                }
            }
        }
    }
};

struct EpiRowsBf16 {
    static constexpr bool PERM = true, AFTER_DRAIN = false; static constexpr int MID_T = 0;
    bf16_t* O; int ldc;
    __device__ __forceinline__ void operator()(const f32x4 (&acc)[2][2][4][2], const pg8::Unit& u, int wr, int wc, int fr, int fq) const {
#pragma unroll
        for (int ai = 0; ai < 2; ++ai)
#pragma unroll
            for (int m = 0; m < 4; ++m) {
                bf16_t* rowp = O + (size_t)(u.pm * 256 + ai * 128 + wr * 64 + m * 16 + fr) * ldc + u.pn * 256 + wc * 32 + 8 * fq;
#pragma unroll
                for (int bj = 0; bj < 2; ++bj) { const f32x4 a0 = acc[ai][bj][m][0], a1 = acc[ai][bj][m][1];
                    v4u w; w.x = pg8::cvt_pk_bf16(a0[0], a0[1]); w.y = pg8::cvt_pk_bf16(a0[2], a0[3]); w.z = pg8::cvt_pk_bf16(a1[0], a1[1]); w.w = pg8::cvt_pk_bf16(a1[2], a1[3]);
                    *(v4u*)(rowp + bj * 128) = w; }
                asm volatile("" ::: "memory");
            }
    }
};
struct EpiWout {
    static constexpr bool PERM = false, AFTER_DRAIN = false; static constexpr int MID_T = 0;
    const float* x; float* out;
    __device__ __forceinline__ void operator()(const f32x4 (&acc)[2][2][4][2], const pg8::Unit& u, int wr, int wc, int fr, int fq) const {
#pragma unroll
        for (int ai = 0; ai < 2; ++ai) {
            f32x4 xv[4][2][2];
#pragma unroll
            for (int m = 0; m < 4; ++m) {
                const size_t roff = (size_t)(u.pm * 256 + ai * 128 + wr * 64 + m * 16 + fr) * D + u.pn * 256 + wc * 32 + 4 * fq;
#pragma unroll
                for (int bj = 0; bj < 2; ++bj)
#pragma unroll
                    for (int n = 0; n < 2; ++n) xv[m][bj][n] = *(const f32x4*)(x + roff + bj * 128 + n * 16);
            }
            asm volatile("" ::: "memory");
#pragma unroll
            for (int m = 0; m < 4; ++m) {
                const size_t roff = (size_t)(u.pm * 256 + ai * 128 + wr * 64 + m * 16 + fr) * D + u.pn * 256 + wc * 32 + 4 * fq;
#pragma unroll
                for (int bj = 0; bj < 2; ++bj)
#pragma unroll
                    for (int n = 0; n < 2; ++n) *(f32x4*)(out + roff + bj * 128 + n * 16) = xv[m][bj][n] * ALPHA + acc[ai][bj][m][n];
            }
            asm volatile("" ::: "memory");
        }
    }
};
constexpr int CONV_EARLY = 0;
__device__ __forceinline__ void moe_weight_convert_range(const Params& p, unsigned char* ldsb, int lo, int hi, int wi, int nw);
__device__ __forceinline__ void ph_wout(const Params& p, unsigned char* ldsb) {
    const int bid = opq_bid(), gsz = opq_grid();
    pg8::Gemm g{1024, 1024, p.wbase};
    TileOrder Sd; Sd.init(p.ws + O_MERGED, p.ws + O_WOUTT, T, 1024, 1024, 1024, gsz, bid);
    EpiRowsBf16 E{(bf16_t*)(p.ws + O_H1B), 1024};
    pg8::gemm_phase<EpiRowsBf16, TileOrder, true, true>((PG8_LAS unsigned char*)ldsb, g, Sd, E);
}
__device__ __forceinline__ unsigned pk2(float lo, float hi) { return (unsigned)f2bf(lo) | ((unsigned)f2bf(hi) << 16); }
__device__ __forceinline__ void p0_transpose_item(const float* W, int K, int N, bf16_t* WT, int mode, LAS float* scr, int item, int lane, int ldo = 0) {
    if (ldo == 0) ldo = K;
    const int nblk = (N + 63) / 64, kb = item / nblk, nb = item % nblk, k0 = 64 * kb, n0 = 64 * nb;
    const int nl = n0 + lane; const bool ok = nl < N;
    const float* wp = W + (size_t)k0 * N + (ok ? nl : 0);
    float wv_[64];
#pragma unroll
    for (int i = 0; i < 64; ++i) wv_[i] = __builtin_nontemporal_load(wp + (size_t)i * N);
#pragma unroll
    for (int i = 0; i < 64; ++i) scr[i * 65 + lane] = ok ? wv_[i] : 0.f;
    asm volatile("s_waitcnt lgkmcnt(0)" ::: "memory");
    const int c = lane & 7;
#pragma unroll
    for (int j = 0; j < 8; ++j) {
        const int n = (lane >> 3) + 8 * j; const LAS float* sp = scr + (8 * c) * 65 + n;
        v4u o; o.x = pk2(sp[0 * 65], sp[1 * 65]); o.y = pk2(sp[2 * 65], sp[3 * 65]); o.z = pk2(sp[4 * 65], sp[5 * 65]); o.w = pk2(sp[6 * 65], sp[7 * 65]);
        const int nn = n0 + n;
        int row = nn;
        if (mode == 1) row = (nn < 512) ? ((nn >> 7) * 256 + (nn & 127)) : ((((nn - 512) >> 7) * 256) + 128 + ((nn - 512) & 127));
        else if (mode == 2) {
            if (nn >= C_MG + 1024) { const int ch = nn - (C_MG + 1024); row = C_BG + (ch >> 7) * 256 + 128 + (ch & 127); }
            else if (nn >= C_MG) { const int ch = nn - C_MG; row = C_BG + (ch >> 7) * 256 + (ch & 127); }
            else if (nn >= C_BG) row = C_BG + 2048 + (nn - C_BG);
        }
        *(v4u*)(WT + (size_t)row * ldo + k0 + 8 * c) = o;
    }
    asm volatile("s_waitcnt lgkmcnt(0)" ::: "memory");
}
__device__ __forceinline__ void ph_prologue(const Params& p, unsigned char* ldsb) {
    const int tid = opq_tid(p.wbase), bid = opq_bid(), gsz = opq_grid(); const int lane = tid & 63, wv = tid >> 6;
    LAS float* scr = (LAS float*)(LAS unsigned char*)ldsb + wv * (64 * 65);
    const int gw = bid * NWAVES + wv, NGW = gsz * NWAVES;
    unsigned char* ws = p.ws;
    constexpr int I_IN = 16 * 89;
    for (int it = gw; it < I_IN; it += NGW) p0_transpose_item(p.w_in, 1024, INC, (bf16_t*)(ws + O_WINT), 2, scr, it, lane);
    bf16_t* XB = (bf16_t*)(ws + O_XB);
    for (int m = gw; m < T; m += 2 * NGW) {
        const f32x4* xr = (const f32x4*)(p.x + (size_t)m * D) + lane; const f32x4* xr2 = (const f32x4*)(p.x + (size_t)(m + NGW) * D) + lane;
        unsigned long long* o8 = (unsigned long long*)(XB + (size_t)m * D) + lane; unsigned long long* o82 = (unsigned long long*)(XB + (size_t)(m + NGW) * D) + lane;
        f32x4 v[8];
#pragma unroll
        for (int j = 0; j < 4; ++j) { v[j] = __builtin_nontemporal_load(xr + 64 * j); v[4 + j] = __builtin_nontemporal_load(xr2 + 64 * j); }
#pragma unroll
        for (int j = 0; j < 4; ++j) { o8[64 * j] = (unsigned long long)pg8::cvt_pk_bf16(v[j][0], v[j][1]) | ((unsigned long long)pg8::cvt_pk_bf16(v[j][2], v[j][3]) << 32);
                                      o82[64 * j] = (unsigned long long)pg8::cvt_pk_bf16(v[4 + j][0], v[4 + j][1]) | ((unsigned long long)pg8::cvt_pk_bf16(v[4 + j][2], v[4 + j][3]) << 32); }
    }
}
__device__ __forceinline__ void prologue_deferred(const Params& p, unsigned char* ldsb, int wi, int nw);
__device__ __forceinline__ void ph_proj(const Params& p, unsigned char* ldsb) {
    const int bid = opq_bid(), gsz = opq_grid();
    pg8::Gemm g{1024, 1024, p.wbase};
    TileOrder Sd; Sd.init(p.ws + O_XB, p.ws + O_WINT, T, NPAD_IN, 1024, 1024, gsz, bid);
    EpiProj E{p.ws, ldsb + 131072};
    pg8::gemm_phase<EpiProj, TileOrder, true, true>((PG8_LAS unsigned char*)ldsb, g, Sd, E);
    const int nwg = (T / 256) * (NPAD_IN / 256), rounds = (nwg + gsz - 1) / gsz, nbusy = nwg - (rounds - 1) * gsz, nidle = gsz - nbusy;
    const int wv = __builtin_amdgcn_readfirstlane(opq_tid(p.wbase) >> 6);
    __syncthreads();
    if (nidle * 4 >= gsz) { if (bid >= nbusy) prologue_deferred(p, ldsb, (bid - nbusy) * NWAVES + wv, nidle * NWAVES); }
    else prologue_deferred(p, ldsb, bid * NWAVES + wv, gsz * NWAVES);
}


struct EpiMerge1 {
    static constexpr bool PERM = true, AFTER_DRAIN = false; static constexpr int MID_T = 4;
    unsigned char* ws;
    __device__ __forceinline__ void mid(f32x4 (&acc)[2][2][4][2], const pg8::Unit& u, int wr, int wc, int fr, int fq) const {
        const bf16_t* MG = (const bf16_t*)(ws + O_MG);
#pragma unroll
        for (int ai = 0; ai < 2; ++ai) {
            v4u gav[4][2];
#pragma unroll
            for (int m = 0; m < 4; ++m) {
                const int row = u.pm * 256 + ai * 128 + wr * 64 + m * 16 + fr;
#pragma unroll
                for (int bj = 0; bj < 2; ++bj) {
                    const int c0 = u.pn * 256 + bj * 128 + wc * 32 + 8 * fq;
                    gav[m][bj] = *(const v4u*)(MG + (size_t)row * 2048 + c0);
                }
            }
            asm volatile("" ::: "memory");
#pragma unroll
            for (int m = 0; m < 4; ++m) {
#pragma unroll
                for (int bj = 0; bj < 2; ++bj) {
                    const v4u ga = gav[m][bj];
                    float ra[8];
                    ra[0] = __uint_as_float(ga.x << 16); ra[1] = __uint_as_float(ga.x & 0xffff0000u); ra[2] = __uint_as_float(ga.y << 16); ra[3] = __uint_as_float(ga.y & 0xffff0000u);
                    ra[4] = __uint_as_float(ga.z << 16); ra[5] = __uint_as_float(ga.z & 0xffff0000u); ra[6] = __uint_as_float(ga.w << 16); ra[7] = __uint_as_float(ga.w & 0xffff0000u);
#pragma unroll
                    for (int j = 0; j < 4; ++j) { acc[ai][bj][m][0][j] *= ra[j]; acc[ai][bj][m][1][j] *= ra[4 + j]; }
                }
            }
            asm volatile("" ::: "memory");
        }
    }
    __device__ __forceinline__ void operator()(const f32x4 (&acc)[2][2][4][2], const pg8::Unit& u, int wr, int wc, int fr, int fq) const {
        const bf16_t* MG = (const bf16_t*)(ws + O_MG); bf16_t* MERGED = (bf16_t*)(ws + O_MERGED);
#pragma unroll
        for (int ai = 0; ai < 2; ++ai) {
            v4u gvv[4][2];
#pragma unroll
            for (int m = 0; m < 4; ++m)
#pragma unroll
                for (int bj = 0; bj < 2; ++bj) gvv[m][bj] = *(const v4u*)(MG + (size_t)(u.pm * 256 + ai * 128 + wr * 64 + m * 16 + fr) * 2048 + 1024 + u.pn * 256 + bj * 128 + wc * 32 + 8 * fq);
            asm volatile("" ::: "memory");
#pragma unroll
            for (int m = 0; m < 4; ++m) {
                const int row = u.pm * 256 + ai * 128 + wr * 64 + m * 16 + fr;
#pragma unroll
                for (int bj = 0; bj < 2; ++bj) {
                    const int c0 = u.pn * 256 + bj * 128 + wc * 32 + 8 * fq;
                    const v4u gv = gvv[m][bj];
                    const f32x4 a0 = acc[ai][bj][m][0], a1 = acc[ai][bj][m][1];
                    float r[8];
                    r[0] = __uint_as_float(gv.x << 16) * a0[0]; r[1] = __uint_as_float(gv.x & 0xffff0000u) * a0[1];
                    r[2] = __uint_as_float(gv.y << 16) * a0[2]; r[3] = __uint_as_float(gv.y & 0xffff0000u) * a0[3];
                    r[4] = __uint_as_float(gv.z << 16) * a1[0]; r[5] = __uint_as_float(gv.z & 0xffff0000u) * a1[1];
                    r[6] = __uint_as_float(gv.w << 16) * a1[2]; r[7] = __uint_as_float(gv.w & 0xffff0000u) * a1[3];
                    v4u w; w.x = pg8::cvt_pk_bf16(r[0], r[1]); w.y = pg8::cvt_pk_bf16(r[2], r[3]); w.z = pg8::cvt_pk_bf16(r[4], r[5]); w.w = pg8::cvt_pk_bf16(r[6], r[7]);
                    *(v4u*)(MERGED + (size_t)row * D + c0) = w;
                }
            }
            asm volatile("" ::: "memory");
        }
    }
};
__device__ __forceinline__ void ph_merge(const Params& p, unsigned char* ldsb) {
    const int bid = opq_bid(), gsz = opq_grid();
    unsigned char* ws = p.ws; asm volatile("" : "+s"(ws));
    pg8::Gemm g{768, 768, p.wbase}; TileOrder Sd; Sd.init(ws + O_YAB, ws + O_WBAT, T, 1024, 768, 768, gsz, bid); EpiMerge1 E{ws};
    pg8::gemm_phase<EpiMerge1, TileOrder, true, true>((PG8_LAS unsigned char*)ldsb, g, Sd, E);
}

constexpr int LDS_TAB = 131072;
__device__ __forceinline__ void moe_tables(const Params& p, unsigned char* ldsb, int ncol, int tid) {
    int* tab = (int*)(ldsb + LDS_TAB);
    if (tid < 64) {
        const int* CNT = (const int*)(p.ws + O_CNT);
        const int cnt = tid < NEXP ? CNT[tid] : 0, nrb = (cnt + 255) >> 8;
        int incl = nrb;
#pragma unroll
        for (int o = 1; o < 32; o <<= 1) { const int v = __shfl_up(incl, o); if (tid >= o) incl += v; }
        const int excl = incl - nrb;
        if (tid < NEXP) { tab[tid] = excl * ncol; tab[40 + tid] = excl * 256; tab[80 + tid] = cnt; }
        if (tid == NEXP - 1) { tab[NEXP] = incl * ncol; tab[40 + NEXP] = incl * 256; }
    }
    __syncthreads();
}
struct MoeOrder {
    const int* tab; int G, c, ncol; const char* A; const char* Bt; size_t arow, bexp, btile; const int* list;
    __device__ __forceinline__ bool next(int i, pg8::Unit& u) const {
        const int nwg = tab[NEXP];
        const int L0 = i * G + c; if (L0 >= nwg) return false;
        int L = L0; { const int q = nwg / 8, r = nwg % 8, xcd = L0 % 8, off = L0 / 8; L = (xcd < r ? xcd * (q + 1) : r * (q + 1) + (xcd - r) * q) + off; }
        const int ln_ = (int)__builtin_amdgcn_mbcnt_hi(~0u, __builtin_amdgcn_mbcnt_lo(~0u, 0u));
        const int tv_ = tab[ln_ < NEXP ? ln_ : 0];
        const int e = __builtin_amdgcn_readfirstlane(__popcll(__ballot(ln_ < NEXP && tv_ <= L)) - 1);
        const int rem = L - tab[e], rb = rem / ncol, pn = rem - rb * ncol;
        u.pm = (tab[40 + e] >> 8) + rb; u.pn = pn; u.b = Bt + (size_t)e * bexp + (size_t)pn * btile;
        if (list) { u.a = A; u.rows = list + (size_t)e * T + rb * 256; u.nrows = tab[80 + e] - rb * 256; } else { u.a = A + (size_t)u.pm * 256 * arow; u.rows = nullptr; u.nrows = 0; }
        return true;
    }
    __device__ __forceinline__ void a_ready(const pg8::Unit&) const {}
    __device__ __forceinline__ void done(const pg8::Unit&) const {}
};
__device__ __forceinline__ void ph_moe_gather(const Params& p, unsigned char* ldsb) {
    const int tid = opq_tid(p.wbase), bid = opq_bid(), gsz = opq_grid(); const int lane = tid & 63, wv = tid >> 6;
    moe_tables(p, ldsb, 4, tid);
    const int* tab = (const int*)(ldsb + LDS_TAB);
    const int* CNT = (const int*)(p.ws + O_CNT); const int* LIST = (const int*)(p.ws + O_LIST);
    const bf16_t* H1B = (const bf16_t*)(p.ws + O_H1B); bf16_t* XG = (bf16_t*)(p.ws + O_XG);
    const int P = tab[40 + NEXP];
    for (int r = bid * NWAVES + wv; r < P; r += gsz * NWAVES) {
        int e = 0;
#pragma unroll 1
        for (int k = 1; k < NEXP; ++k) if (tab[40 + k] <= r) e = k;
        const int slot = r - tab[40 + e];
        v4u v0 = {0u, 0u, 0u, 0u}, v1 = {0u, 0u, 0u, 0u};
        if (slot < CNT[e]) { const int tok = LIST[(size_t)e * T + slot] >> 1; const v4u* src = (const v4u*)(H1B + (size_t)tok * D); v0 = src[lane]; v1 = src[64 + lane]; }
        v4u* dst = (v4u*)(XG + (size_t)r * D); dst[lane] = v0; dst[64 + lane] = v1;
    }
}
struct EpiSwiGLU {
    static constexpr bool PERM = true, AFTER_DRAIN = false; static constexpr int MID_T = 0;
    bf16_t* ACT;
    __device__ __forceinline__ void operator()(const f32x4 (&acc)[2][2][4][2], const pg8::Unit& u, int wr, int wc, int fr, int fq) const {
#pragma unroll
        for (int ai = 0; ai < 2; ++ai)
#pragma unroll
            for (int m = 0; m < 4; ++m) {
                const int row = u.pm * 256 + ai * 128 + wr * 64 + m * 16 + fr;
                float r[8];
#pragma unroll
                for (int n = 0; n < 2; ++n)
#pragma unroll
                    for (int j = 0; j < 4; ++j) { const float gv = acc[ai][0][m][n][j]; r[n * 4 + j] = gv * __builtin_amdgcn_rcpf(1.f + __expf(-gv)) * acc[ai][1][m][n][j]; }
                v4u w; w.x = pg8::cvt_pk_bf16(r[0], r[1]); w.y = pg8::cvt_pk_bf16(r[2], r[3]); w.z = pg8::cvt_pk_bf16(r[4], r[5]); w.w = pg8::cvt_pk_bf16(r[6], r[7]);
                *(v4u*)(ACT + (size_t)row * DEXP + u.pn * 128 + wc * 32 + 8 * fq) = w;
                asm volatile("" ::: "memory");
            }
    }
};
__device__ __forceinline__ void ph_moe_up(const Params& p, unsigned char* ldsb) {
    const int tid = opq_tid(p.wbase), bid = opq_bid(), gsz = opq_grid();
    moe_tables(p, ldsb, 4, tid);
    pg8::Gemm g{1024, 1024, p.wbase};
    MoeOrder Sd{(const int*)(ldsb + LDS_TAB), gsz, bid, 4, (const char*)(p.ws + O_H1B), (const char*)(p.ws + O_WGUT), (size_t)1024 * 2, (size_t)1024 * 1024 * 2, (size_t)256 * 1024 * 2, (const int*)(p.ws + O_LIST)};
    EpiSwiGLU E{(bf16_t*)(p.ws + O_ACT)};
    pg8::gemm_phase<EpiSwiGLU, MoeOrder, true, true, true>((PG8_LAS unsigned char*)ldsb, g, Sd, E);
}
__device__ __forceinline__ void ph_moe_down(const Params& p, unsigned char* ldsb) {
    const int tid = opq_tid(p.wbase), bid = opq_bid(), gsz = opq_grid();
    moe_tables(p, ldsb, 4, tid);
    pg8::Gemm g{512, 512, p.wbase};
    MoeOrder Sd{(const int*)(ldsb + LDS_TAB), gsz, bid, 4, (const char*)(p.ws + O_ACT), (const char*)(p.ws + O_WDT), (size_t)512 * 2, (size_t)1024 * 512 * 2, (size_t)256 * 512 * 2, nullptr};
    EpiRowsBf16 E{(bf16_t*)(p.ws + O_YE), 1024};
    pg8::gemm_phase<EpiRowsBf16, MoeOrder, true, true>((PG8_LAS unsigned char*)ldsb, g, Sd, E);
}
__device__ __forceinline__ void moe_weight_convert_range(const Params& p, unsigned char* ldsb, int lo, int hi, int wi, int nw) {
    const int tid = opq_tid(p.wbase); const int lane = tid & 63, wv = tid >> 6;
    LAS float* scr = (LAS float*)(LAS unsigned char*)ldsb + wv * (64 * 65);
    constexpr int I_GU = 16 * 16, I_D = 8 * 16;
    for (int it = lo + wi; it < hi; it += nw) {
        if (it < NEXP * I_GU) { const int e = it / I_GU; p0_transpose_item(p.w_gate_up + (size_t)e * 1024 * 1024, 1024, 1024, (bf16_t*)(p.ws + O_WGUT) + (size_t)e * 1024 * 1024, 1, scr, it % I_GU, lane); }
        else { const int r = it - NEXP * I_GU, e = r / I_D; p0_transpose_item(p.w_down + (size_t)e * 512 * 1024, 512, 1024, (bf16_t*)(p.ws + O_WDT) + (size_t)e * 1024 * 512, 0, scr, r % I_D, lane); }
    }
}
__device__ __forceinline__ void ph_final2(const Params& p) {
    const int tid = opq_tid(p.wbase), bid = opq_bid(), gsz = opq_grid(); const int lane = tid & 63, wv = tid >> 6;
    const bf16_t* YE = (const bf16_t*)(p.ws + O_YE); const float* WTS = (const float*)(p.ws + O_WTS); const int* ES = (const int*)(p.ws + O_ES); const int* CNT = (const int*)(p.ws + O_CNT);
    const bf16_t* H1B = (const bf16_t*)(p.ws + O_H1B);
    int pst = 0;
    { const int pc = lane < NEXP ? (((CNT[lane] + 255) >> 8) << 8) : 0; int incl = pc;
#pragma unroll
      for (int o = 1; o < 32; o <<= 1) { const int v = __shfl_up(incl, o); if (lane >= o) incl += v; }
      pst = incl - pc; }
    const int NGW = gsz * NWAVES;
    const bool pref = T <= 64 * NGW;
    float pw0 = 0.f, pw1 = 0.f; int pe0 = 0, pe1 = 0;
    { const int tj = bid * NWAVES + wv + lane * NGW; if (pref && tj < T) { pw0 = WTS[2 * tj]; pw1 = WTS[2 * tj + 1]; pe0 = ES[2 * tj]; pe1 = ES[2 * tj + 1]; } }
    float4 gg4[4], bb4[4];
#pragma unroll
    for (int j = 0; j < 4; ++j) { gg4[j] = *(const float4*)(p.ln2_g + j * 256 + lane * 4); bb4[j] = *(const float4*)(p.ln2_b + j * 256 + lane * 4); }
    int it_ = 0;
    for (int t0_ = bid * NWAVES + wv; t0_ < T; t0_ += 2 * NGW, ++it_) {
        float v[2][16];
#pragma unroll
        for (int u = 0; u < 2; ++u) {
            const int t = t0_ + u * NGW;
            const bf16_t* row = H1B + (size_t)t * D;
            const int jj = 2 * it_ + u;
            const float w0 = pref ? __shfl(pw0, jj) : WTS[2 * t], w1 = pref ? __shfl(pw1, jj) : WTS[2 * t + 1];
            const int es0 = pref ? __shfl(pe0, jj) : ES[2 * t], es1 = pref ? __shfl(pe1, jj) : ES[2 * t + 1];
            const size_t pos0 = (size_t)(__shfl(pst, es0 >> 16) + (es0 & 0xffff)), pos1 = (size_t)(__shfl(pst, es1 >> 16) + (es1 & 0xffff));
#pragma unroll
            for (int j = 0; j < 4; ++j) {
                typedef unsigned short nt_us4 __attribute__((ext_vector_type(4)));
                const nt_us4 fb = __builtin_nontemporal_load((const nt_us4*)(row + j * 256 + lane * 4)); const float4 f = make_float4(bf2f(fb.x), bf2f(fb.y), bf2f(fb.z), bf2f(fb.w));
                const nt_us4 a = __builtin_nontemporal_load((const nt_us4*)(YE + pos0 * D + j * 256 + lane * 4)), bq = __builtin_nontemporal_load((const nt_us4*)(YE + pos1 * D + j * 256 + lane * 4));
                v[u][j * 4] = ALPHA * f.x + w0 * bf2f(a.x) + w1 * bf2f(bq.x); v[u][j * 4 + 1] = ALPHA * f.y + w0 * bf2f(a.y) + w1 * bf2f(bq.y);
                v[u][j * 4 + 2] = ALPHA * f.z + w0 * bf2f(a.z) + w1 * bf2f(bq.z); v[u][j * 4 + 3] = ALPHA * f.w + w0 * bf2f(a.w) + w1 * bf2f(bq.w);
            }
        }
        float mu[2], rstd[2];
#pragma unroll
        for (int u = 0; u < 2; ++u) { float sm = 0.f;
#pragma unroll
            for (int j = 0; j < 16; ++j) sm += v[u][j];
            mu[u] = sm; }
        mu[0] = wave_sum(mu[0]) * (1.f / D); mu[1] = wave_sum(mu[1]) * (1.f / D);
#pragma unroll
        for (int u = 0; u < 2; ++u) { float sq = 0.f;
#pragma unroll
            for (int j = 0; j < 16; ++j) { v[u][j] -= mu[u]; sq += v[u][j] * v[u][j]; }
            rstd[u] = sq; }
        rstd[0] = rsqrtf(wave_sum(rstd[0]) * (1.f / D) + LN_EPS); rstd[1] = rsqrtf(wave_sum(rstd[1]) * (1.f / D) + LN_EPS);
#pragma unroll
        for (int u = 0; u < 2; ++u) {
            float* row = p.out + (size_t)(t0_ + u * NGW) * D;
#pragma unroll
            for (int j = 0; j < 4; ++j) {
                const float4 gg = gg4[j], bb = bb4[j];
                typedef float nt_f4 __attribute__((ext_vector_type(4)));
                const nt_f4 ov = { v[u][j * 4] * rstd[u] * gg.x + bb.x, v[u][j * 4 + 1] * rstd[u] * gg.y + bb.y, v[u][j * 4 + 2] * rstd[u] * gg.z + bb.z, v[u][j * 4 + 3] * rstd[u] * gg.w + bb.w };
                __builtin_nontemporal_store(ov, (nt_f4*)(row + j * 256 + lane * 4));
            }
        }
    }
}

typedef short bf16x8 __attribute__((ext_vector_type(8)));
#define MFMA16(a, b, c) __builtin_amdgcn_mfma_f32_16x16x32_bf16((a), (b), (c), 0, 0, 0)
constexpr float LOG2E = 1.4426950408889634f, LN2 = 0.6931471805599453f;
constexpr float QK_C = 1.0f;
__device__ __forceinline__ bf16x8 pack_p(const f32x4 p0, const f32x4 p1) {
    v4u w; w.x = pg8::cvt_pk_bf16(p0[0], p0[1]); w.y = pg8::cvt_pk_bf16(p0[2], p0[3]); w.z = pg8::cvt_pk_bf16(p1[0], p1[1]); w.w = pg8::cvt_pk_bf16(p1[2], p1[3]);
    return __builtin_bit_cast(bf16x8, w);
}
__device__ __forceinline__ void load_kf(bf16x8 (&kf)[2][2], const bf16_t* Kp, int i, int h) {
    const bf16_t* r0 = Kp + (size_t)(8 * (i >> 2) + (i & 3)) * 64 + 8 * h;
    kf[0][0] = *(const bf16x8*)(r0); kf[0][1] = *(const bf16x8*)(r0 + 32);
    kf[1][0] = *(const bf16x8*)(r0 + 4 * 64); kf[1][1] = *(const bf16x8*)(r0 + 4 * 64 + 32);
}
__device__ __forceinline__ void load_vf(bf16x8 (&vf)[4], const bf16_t* VTp, size_t vstride, int i, int h) {
#pragma unroll
    for (int dt = 0; dt < 4; ++dt) vf[dt] = *(const bf16x8*)(VTp + (size_t)(16 * dt + i) * vstride + 8 * h);
}
__device__ __forceinline__ float hmax4(float v) {
    auto a = __builtin_amdgcn_permlane16_swap(__float_as_uint(v), __float_as_uint(v), false, false);
    v = fmaxf(__uint_as_float(a[0]), __uint_as_float(a[1]));
    auto b = __builtin_amdgcn_permlane32_swap(__float_as_uint(v), __float_as_uint(v), false, false);
    return fmaxf(__uint_as_float(b[0]), __uint_as_float(b[1]));
}
__device__ __forceinline__ float hsum4(float v) {
    auto a = __builtin_amdgcn_permlane16_swap(__float_as_uint(v), __float_as_uint(v), false, false);
    v = __uint_as_float(a[0]) + __uint_as_float(a[1]);
    auto b = __builtin_amdgcn_permlane32_swap(__float_as_uint(v), __float_as_uint(v), false, false);
    return __uint_as_float(b[0]) + __uint_as_float(b[1]);
}
__device__ __forceinline__ int isum_h4(int v) {
    auto a = __builtin_amdgcn_permlane16_swap((unsigned)v, (unsigned)v, false, false);
    v = (int)(a[0] + a[1]);
    auto b = __builtin_amdgcn_permlane32_swap((unsigned)v, (unsigned)v, false, false);
    return (int)(b[0] + b[1]);
}
__device__ __forceinline__ void softmax_step(f32x4& x0, f32x4& x1, unsigned vm0, unsigned vm1, float& m, float& l, f32x4 (&o)[4]) {
    float tm = fmaxf(fmaxf(fmaxf(x0[0], x0[1]), fmaxf(x0[2], x0[3])), fmaxf(fmaxf(x1[0], x1[1]), fmaxf(x1[2], x1[3])));
    tm = hmax4(tm);
    const float mn = fmaxf(m, tm);
    const float alpha = __builtin_amdgcn_exp2f(m - mn);
    m = mn;
    float sum = 0.f;
#pragma unroll
    for (int r = 0; r < 4; ++r) {
        x0[r] = (vm0 >> r) & 1u ? __builtin_amdgcn_exp2f(x0[r] - mn) : 0.f;
        x1[r] = (vm1 >> r) & 1u ? __builtin_amdgcn_exp2f(x1[r] - mn) : 0.f;
        sum += x0[r] + x1[r];
    }
    l = l * alpha + sum;
#pragma unroll
    for (int dt = 0; dt < 4; ++dt) o[dt] = o[dt] * alpha;
}

__device__ __forceinline__ void ph_dilated(const Params& p) {
    const int tid = opq_tid(p.wbase), bid = opq_bid(), gsz = opq_grid(); const int lane = tid & 63, wv = tid >> 6, i = lane & 15, h = lane >> 4;
    const bf16_t* QA = (const bf16_t*)(p.ws + O_QA); const bf16_t* KA = (const bf16_t*)(p.ws + O_KA); const bf16_t* VAT = (const bf16_t*)(p.ws + O_VAT);
    bf16_t* OG = (bf16_t*)(p.ws + O_OG); float* LSE = (float*)(p.ws + O_LSE);
    int* ctr = (int*)(p.ws + O_CNT) + 66;
    for (;;) {
        int task0 = 0; if (lane == 0) task0 = atomicAdd(ctr, 4); task0 = __builtin_amdgcn_readfirstlane(task0);
        if (task0 >= NB * 12 * (S / 32)) break;
#pragma unroll 1
        for (int task = task0; task < task0 + 4; ++task) {
        const int qb = task & 255, bgh = task >> 8, hd = bgh & 3, g = (bgh >> 2) % 3, b = bgh / 12;
        const int sh = 2 * g, d = 1 << sh, L = S >> sh, P0 = qb * 32, r = P0 / L, l0 = P0 - r * L;
        const float slope2 = exp2f(-8.0f * (float)(g * 4 + hd + 1) / 12.0f) * LOG2E * (float)d;
        const size_t base = (size_t)bgh;
        const bf16_t* Qp = QA + (base * S + P0) * 64;
        bf16x8 qf[2][2];
#pragma unroll
        for (int qt = 0; qt < 2; ++qt) { qf[qt][0] = *(const bf16x8*)(Qp + (size_t)(qt * 16 + i) * 64 + 8 * h); qf[qt][1] = *(const bf16x8*)(Qp + (size_t)(qt * 16 + i) * 64 + 8 * h + 32); }
        float m[2] = {-1e30f, -1e30f}, l[2] = {0.f, 0.f};
        f32x4 o[2][4];
#pragma unroll
        for (int qt = 0; qt < 2; ++qt)
#pragma unroll
            for (int dt = 0; dt < 4; ++dt) o[qt][dt] = (f32x4){0.f, 0.f, 0.f, 0.f};
#pragma unroll 1
        for (int kt = 0; kt < 5; ++kt) {
            const int key0 = l0 - 128 + 32 * kt;
            if (key0 < 0) continue;
            bf16x8 kf[2][2], vf[4];
            load_kf(kf, KA + (base * S + (size_t)r * L + key0) * 64, i, h);
            load_vf(vf, VAT + (base * 64) * S + (size_t)r * L + key0, S, i, h);
#pragma unroll
            for (int qt = 0; qt < 2; ++qt) {
                f32x4 x0 = MFMA16(kf[0][0], qf[qt][0], ((f32x4){0.f, 0.f, 0.f, 0.f})); x0 = MFMA16(kf[0][1], qf[qt][1], x0);
                f32x4 x1 = MFMA16(kf[1][0], qf[qt][0], ((f32x4){0.f, 0.f, 0.f, 0.f})); x1 = MFMA16(kf[1][1], qf[qt][1], x1);
                const int dq = (l0 + qt * 16 + i) - (key0 + 8 * h);
                unsigned vm0 = 0u, vm1 = 0u;
#pragma unroll
                for (int rr = 0; rr < 4; ++rr) {
                    const int d0 = dq - rr, d1 = dq - 4 - rr;
                    const bool ok0 = d0 >= 0 && d0 <= 128, ok1 = d1 >= 0 && d1 <= 128;
                    x0[rr] = ok0 ? x0[rr] * QK_C - slope2 * (float)d0 : -1e30f; x1[rr] = ok1 ? x1[rr] * QK_C - slope2 * (float)d1 : -1e30f;
                    vm0 |= ok0 ? (1u << rr) : 0u; vm1 |= ok1 ? (1u << rr) : 0u;
                }
                softmax_step(x0, x1, vm0, vm1, m[qt], l[qt], o[qt]);
                const bf16x8 pf = pack_p(x0, x1);
#pragma unroll
                for (int dt = 0; dt < 4; ++dt) o[qt][dt] = MFMA16(vf[dt], pf, o[qt][dt]);
            }
        }
#pragma unroll
        for (int qt = 0; qt < 2; ++qt) {
            float lt = l[qt]; lt = hsum4(lt);
            const float inv = 1.f / lt;
            const int sp = (l0 + qt * 16 + i) * d + r;
            const size_t t = (size_t)b * S + sp;
            bf16_t* op = OG + (t * 3 + g) * 256 + hd * 64 + 4 * h;
#pragma unroll
            for (int dt = 0; dt < 4; ++dt) {
                const f32x4 v = o[qt][dt] * inv;
                uint2 w; w.x = pg8::cvt_pk_bf16(v[0], v[1]); w.y = pg8::cvt_pk_bf16(v[2], v[3]);
                *(uint2*)(op + 16 * dt) = w;
            }
            if (h == 0) LSE[t * 12 + g * 4 + hd] = (m[qt] + log2f(lt)) * LN2;
        }
        }
    }
}
__device__ __forceinline__ void ph_combine(const Params& p) {
    const int tid = opq_tid(p.wbase), bid = opq_bid(), gsz = opq_grid(); const int lane = tid & 63, wv = tid >> 6;
    const bf16_t* OG = (const bf16_t*)(p.ws + O_OG); const float* LSE = (const float*)(p.ws + O_LSE); bf16_t* YA = (bf16_t*)(p.ws + O_YAB);
    const int hd = lane >> 4;
    const int NGW = gsz * NWAVES;
    for (int tb_ = bid * NWAVES + wv; tb_ < T; tb_ += 4 * NGW) {
        float ls[4][3]; uint2 og[4][3];
#pragma unroll
        for (int u = 0; u < 4; ++u) {
            const int t = tb_ + u * NGW < T ? tb_ + u * NGW : tb_;
#pragma unroll
            for (int k = 0; k < 3; ++k) { ls[u][k] = LSE[(size_t)t * 12 + 4 * k + hd]; { const unsigned long long q_ = __builtin_nontemporal_load((const unsigned long long*)(OG + ((size_t)t * 3 + k) * 256 + lane * 4)); og[u][k].x = (unsigned)q_; og[u][k].y = (unsigned)(q_ >> 32); } }
        }
#pragma unroll
        for (int u = 0; u < 4; ++u) {
            const int t = tb_ + u * NGW;
            if (t < T) {
                const float l0 = ls[u][0], l1 = ls[u][1], l2 = ls[u][2];
                const float mx = fmaxf(l0, fmaxf(l1, l2));
                float w0 = expf(l0 - mx), w1 = expf(l1 - mx), w2 = expf(l2 - mx);
                const float inv = 1.f / (w0 + w1 + w2); w0 *= inv; w1 *= inv; w2 *= inv;
                const uint2 a = og[u][0], bb = og[u][1], c = og[u][2];
                const float r0 = w0 * __uint_as_float(a.x << 16) + w1 * __uint_as_float(bb.x << 16) + w2 * __uint_as_float(c.x << 16);
                const float r1 = w0 * __uint_as_float(a.x & 0xffff0000u) + w1 * __uint_as_float(bb.x & 0xffff0000u) + w2 * __uint_as_float(c.x & 0xffff0000u);
                const float r2 = w0 * __uint_as_float(a.y << 16) + w1 * __uint_as_float(bb.y << 16) + w2 * __uint_as_float(c.y << 16);
                const float r3 = w0 * __uint_as_float(a.y & 0xffff0000u) + w1 * __uint_as_float(bb.y & 0xffff0000u) + w2 * __uint_as_float(c.y & 0xffff0000u);
                uint2 w; w.x = pg8::cvt_pk_bf16(r0, r1); w.y = pg8::cvt_pk_bf16(r2, r3);
                *(uint2*)(YA + (size_t)t * 768 + lane * 4) = w;
            }
        }
    }
}

__device__ __forceinline__ void ml_step(const f32x4 x0, const f32x4 x1, unsigned vm0, unsigned vm1, float& m, float& l) {
    float tm = fmaxf(fmaxf(fmaxf(x0[0], x0[1]), fmaxf(x0[2], x0[3])), fmaxf(fmaxf(x1[0], x1[1]), fmaxf(x1[2], x1[3])));
    tm = hmax4(tm);
    const float mn = fmaxf(m, tm);
    float sum = 0.f;
#pragma unroll
    for (int r = 0; r < 4; ++r) { sum += ((vm0 >> r) & 1u) ? __builtin_amdgcn_exp2f(x0[r] - mn) : 0.f; sum += ((vm1 >> r) & 1u) ? __builtin_amdgcn_exp2f(x1[r] - mn) : 0.f; }
    l = l * __builtin_amdgcn_exp2f(m - mn) + sum; m = mn;
}

struct CmpOrder {
    int G, c; const char* A0; const char* A1; const char* B0; const char* B1; size_t tstepA;
    __device__ __forceinline__ bool next(int i, pg8::Unit& u) const {
        const int L = i * G + c; if (L >= 32) return false;
        const int kv = L >> 4, rt = L & 15;
        u.pm = kv * 16 + rt; u.pn = 0; u.a = (kv ? A1 : A0) + (size_t)rt * tstepA; u.b = kv ? B1 : B0; u.rows = nullptr; u.nrows = 0; return true;
    }
    __device__ __forceinline__ void a_ready(const pg8::Unit&) const {}
    __device__ __forceinline__ void done(const pg8::Unit&) const {}
};
__device__ __forceinline__ float gelu_tanh_fast(float v) {
    const float u = 0.7978845608028654f * (v + 0.044715f * v * v * v);
    const float e = __expf(2.f * u);
    return 0.5f * v * (2.f - 2.f * __builtin_amdgcn_rcpf(e + 1.f));
}
struct EpiCmp1 {
    static constexpr bool PERM = true, AFTER_DRAIN = false; static constexpr int MID_T = 0;
    bf16_t* HID; const float* CB;
    __device__ __forceinline__ void operator()(const f32x4 (&acc)[2][2][4][2], const pg8::Unit& u, int wr, int wc, int fr, int fq) const {
        const float* bias = CB + (u.pm >> 4) * 256;
#pragma unroll
        for (int ai = 0; ai < 2; ++ai)
#pragma unroll
            for (int m = 0; m < 4; ++m) {
                bf16_t* rowp = HID + (size_t)(u.pm * 256 + ai * 128 + wr * 64 + m * 16 + fr) * 256 + wc * 32 + 8 * fq;
#pragma unroll
                for (int bj = 0; bj < 2; ++bj) {
                    const f32x4 b0 = *(const f32x4*)(bias + bj * 128 + wc * 32 + 8 * fq), b1 = *(const f32x4*)(bias + bj * 128 + wc * 32 + 8 * fq + 4);
                    const f32x4 a0 = acc[ai][bj][m][0] + b0, a1 = acc[ai][bj][m][1] + b1;
                    v4u w; w.x = pg8::cvt_pk_bf16(gelu_tanh_fast(a0[0]), gelu_tanh_fast(a0[1])); w.y = pg8::cvt_pk_bf16(gelu_tanh_fast(a0[2]), gelu_tanh_fast(a0[3]));
                    w.z = pg8::cvt_pk_bf16(gelu_tanh_fast(a1[0]), gelu_tanh_fast(a1[1])); w.w = pg8::cvt_pk_bf16(gelu_tanh_fast(a1[2]), gelu_tanh_fast(a1[3]));
                    *(v4u*)(rowp + bj * 128) = w;
                }
                asm volatile("" ::: "memory");
            }
    }
};
struct EpiCmp2 {
    static constexpr bool PERM = true, AFTER_DRAIN = false; static constexpr int MID_T = 0;
    unsigned char* ws;
    __device__ __forceinline__ void operator()(const f32x4 (&acc)[2][2][4][2], const pg8::Unit& u, int wr, int wc, int fr, int fq) const {
        if (wc >= 2) return;
        const int kv = u.pm >> 4, c0 = wc * 32 + 8 * fq;
#pragma unroll
        for (int ai = 0; ai < 2; ++ai)
#pragma unroll
            for (int m = 0; m < 4; ++m) {
                const int R = (u.pm & 15) * 256 + ai * 128 + wr * 64 + m * 16 + fr, bg = R >> 9, c = R & 511;
                const f32x4 a0 = acc[ai][0][m][0], a1 = acc[ai][0][m][1];
                if (kv == 0) {
                    v4u w; w.x = pg8::cvt_pk_bf16(a0[0], a0[1]); w.y = pg8::cvt_pk_bf16(a0[2], a0[3]); w.z = pg8::cvt_pk_bf16(a1[0], a1[1]); w.w = pg8::cvt_pk_bf16(a1[2], a1[3]);
                    *(v4u*)((bf16_t*)(ws + O_KC) + ((size_t)bg * 512 + c) * 64 + c0) = w;
                } else {
                    bf16_t* tp = (bf16_t*)(ws + O_VCT) + ((size_t)bg * 64 + c0) * 512 + c;
                    tp[0] = f2bf(a0[0]); tp[512] = f2bf(a0[1]); tp[1024] = f2bf(a0[2]); tp[1536] = f2bf(a0[3]);
                    tp[2048] = f2bf(a1[0]); tp[2560] = f2bf(a1[1]); tp[3072] = f2bf(a1[2]); tp[3584] = f2bf(a1[3]);
                }
            }
    }
};
__device__ __forceinline__ void ph_cmp1(const Params& p, unsigned char* ldsb) {
    const int bid = opq_bid(), gsz = opq_grid();
    unsigned char* ws = p.ws;
    pg8::Gemm g{2048, 1024, p.wbase};
    CmpOrder Sd{gsz, bid, (const char*)(ws + O_CK), (const char*)(ws + O_CV), (const char*)(ws + O_WC1KT), (const char*)(ws + O_WC1VT), (size_t)256 * 1024 * 2};
    EpiCmp1 E{(bf16_t*)(ws + O_HID), (const float*)(ws + O_CB)};
    pg8::gemm_phase<EpiCmp1, CmpOrder, true, true>((PG8_LAS unsigned char*)ldsb, g, Sd, E);
}
__device__ __forceinline__ void ph_cmp2(const Params& p, unsigned char* ldsb) {
    const int bid = opq_bid(), gsz = opq_grid();
    unsigned char* ws = p.ws;
    pg8::Gemm g{256, 256, p.wbase};
    CmpOrder Sd{gsz, bid, (const char*)(ws + O_HID), (const char*)(ws + O_HID) + (size_t)4096 * 256 * 2, (const char*)(ws + O_WC2T), (const char*)(ws + O_WC2T) + (size_t)256 * 256 * 2, (size_t)256 * 256 * 2};
    EpiCmp2 E{ws};
    pg8::gemm_phase<EpiCmp2, CmpOrder, true, true>((PG8_LAS unsigned char*)ldsb, g, Sd, E);
}
__device__ __forceinline__ void prologue_deferred(const Params& p, unsigned char* ldsb, int wi, int nw) {
    const int tid = opq_tid(p.wbase); const int lane = tid & 63, wv = tid >> 6;
    unsigned char* ws = p.ws;
    {
        LAS float* scr = (LAS float*)(LAS unsigned char*)ldsb + wv * (64 * 65);
        constexpr int I_BA = 4 * 16, I_BB = 8 * 16, I_OUT = 16 * 16, I_C1 = 32 * 4;
        for (int it = wi; it < I_BA + I_BB + I_OUT + 2 * I_C1; it += nw) {
            int r = it;
            if (r < I_BA) { p0_transpose_item(p.w_br_a, 256, 1024, (bf16_t*)(ws + O_WBAT), 0, scr, r, lane, 768); continue; } r -= I_BA;
            if (r < I_BB) { p0_transpose_item(p.w_br_b, 512, 1024, (bf16_t*)(ws + O_WBAT) + 256, 0, scr, r, lane, 768); continue; } r -= I_BB;
            if (r < I_OUT) { p0_transpose_item(p.w_out, 1024, 1024, (bf16_t*)(ws + O_WOUTT), 0, scr, r, lane); continue; } r -= I_OUT;
            if (r < I_C1) { p0_transpose_item(p.cmp_w1_k, 2048, 256, (bf16_t*)(ws + O_WC1KT), 0, scr, r, lane); continue; } r -= I_C1;
            p0_transpose_item(p.cmp_w1_v, 2048, 256, (bf16_t*)(ws + O_WC1VT), 0, scr, r, lane);
        }
    }
    float* CB = (float*)(ws + O_CB);
    for (int o = wi; o < 512; o += nw) {
        const int kv = o >> 8, n = o & 255; const float* pos = kv ? p.cmp_pos_v : p.cmp_pos_k; const float* w1 = kv ? p.cmp_w1_v : p.cmp_w1_k;
        float a = 0.f;
#pragma unroll 8
        for (int k = lane; k < 2048; k += 64) a += pos[k] * w1[(size_t)k * 256 + n];
        a = wave_sum(a);
        if (lane == 0) CB[o] = a;
    }
    bf16_t* WC2T = (bf16_t*)(ws + O_WC2T); bf16_t* WRT = (bf16_t*)(ws + O_WRT);
    const int gt = wi * 64 + lane, ngt = nw * 64;
    for (int e = gt; e < 2 * 256 * 256; e += ngt) {
        const int kv = e >> 16, n = (e >> 8) & 255, k = e & 255; const float* w2 = kv ? p.cmp_w2_v : p.cmp_w2_k;
        WC2T[e] = n < 64 ? f2bf(w2[k * 64 + n]) : (bf16_t)0;
    }
    for (int e = gt; e < 48 * 1024; e += ngt) {
        const int col = e >> 10, k = e & 1023;
        float v = 0.f;
        if (col < 4) v = p.w_coarse[k * 4 + col]; else if (col < 36) v = p.w_fine[((size_t)((col - 4) >> 3) * D + k) * 8 + ((col - 4) & 7)];
        const bf16_t hi = f2bf(v); WRT[e] = hi; WRT[48 * 1024 + e] = f2bf(v - bf2f(hi));
    }
}
__device__ __forceinline__ void ph_ln1_route2(const Params& p, unsigned char* ldsb) {
    const int tid = opq_tid(p.wbase), bid = opq_bid(), gsz = opq_grid(); const int lane = tid & 63, wv = tid >> 6, i = lane & 15, h = lane >> 4;
    unsigned char* ws = p.ws;
    bf16_t* H1B = (bf16_t*)(ws + O_H1B); bf16_t* H1L = (bf16_t*)(ws + O_H1L);
    int* LIST = (int*)(ws + O_LIST); float* WTS = (float*)(ws + O_WTS); int* CNT = (int*)(ws + O_CNT); int* ES = (int*)(ws + O_ES);
    const bf16_t* WRT = (const bf16_t*)(ws + O_WRT);
    float* lg = (float*)(ldsb + wv * 3328);
    int* cntl = (int*)(ldsb + 8 * 3328);
    float4 g1v[4], b1v[4];
#pragma unroll
    for (int j = 0; j < 4; ++j) { g1v[j] = *(const float4*)(p.ln1_g + j * 256 + lane * 4); b1v[j] = *(const float4*)(p.ln1_b + j * 256 + lane * 4); }
    const int niter = (T + gsz * 128 - 1) / (gsz * 128);
    for (int it = 0; it < niter; ++it) {
        const int tb = (it * gsz + bid) * 128 + wv * 16;
        const bool inr = tb < T;
        int ex1 = 0, ex2 = 0; float rw1 = 0.f, rw2 = 0.f;
        if (tid < 32) cntl[tid] = 0;
        if (inr) {
#pragma unroll 1
        for (int tt = 0; tt < 16; tt += 2) {
            float v[2][16];
#pragma unroll
            for (int u = 0; u < 2; ++u) { const float* row = p.x + (size_t)(tb + tt + u) * D; const bf16_t* yrow = H1B + (size_t)(tb + tt + u) * D;
#pragma unroll
                for (int j = 0; j < 4; ++j) { const f32x4 f = __builtin_nontemporal_load((const f32x4*)(row + j * 256 + lane * 4)); typedef unsigned short nt_us4 __attribute__((ext_vector_type(4))); const nt_us4 yb = __builtin_nontemporal_load((const nt_us4*)(yrow + j * 256 + lane * 4));
                    v[u][j * 4] = ALPHA * f.x + bf2f(yb.x); v[u][j * 4 + 1] = ALPHA * f.y + bf2f(yb.y); v[u][j * 4 + 2] = ALPHA * f.z + bf2f(yb.z); v[u][j * 4 + 3] = ALPHA * f.w + bf2f(yb.w); } }
            float mu[2], rstd[2];
#pragma unroll
            for (int u = 0; u < 2; ++u) { float sm = 0.f;
#pragma unroll
                for (int j = 0; j < 16; ++j) sm += v[u][j];
                mu[u] = sm; }
            mu[0] = wave_sum(mu[0]) * (1.f / D); mu[1] = wave_sum(mu[1]) * (1.f / D);
#pragma unroll
            for (int u = 0; u < 2; ++u) { float sq = 0.f;
#pragma unroll
                for (int j = 0; j < 16; ++j) { v[u][j] -= mu[u]; sq += v[u][j] * v[u][j]; }
                rstd[u] = sq; }
            rstd[0] = rsqrtf(wave_sum(rstd[0]) * (1.f / D) + LN_EPS); rstd[1] = rsqrtf(wave_sum(rstd[1]) * (1.f / D) + LN_EPS);
#pragma unroll
            for (int u = 0; u < 2; ++u) {
                const int t = tb + tt + u;
#pragma unroll
                for (int j = 0; j < 4; ++j) {
                    const float4 gg = g1v[j], bb = b1v[j];
                    const float a0 = v[u][j * 4] * rstd[u] * gg.x + bb.x, a1 = v[u][j * 4 + 1] * rstd[u] * gg.y + bb.y, a2 = v[u][j * 4 + 2] * rstd[u] * gg.z + bb.z, a3 = v[u][j * 4 + 3] * rstd[u] * gg.w + bb.w;
                    const unsigned h01 = pg8::cvt_pk_bf16(a0, a1), h23 = pg8::cvt_pk_bf16(a2, a3);
                    *(uint2*)(H1B + (size_t)t * D + j * 256 + lane * 4) = make_uint2(h01, h23);
                }
            }
        }
        asm volatile("s_waitcnt vmcnt(0)" ::: "memory");
        f32x4 acc[3] = {{0.f, 0.f, 0.f, 0.f}, {0.f, 0.f, 0.f, 0.f}, {0.f, 0.f, 0.f, 0.f}};
        const bf16_t* ah = H1B + (size_t)(tb + i) * D + 8 * h;
        LAS unsigned char* Wl = (LAS unsigned char*)ldsb + 32768;
#pragma unroll 1
        for (int hh = 0; hh < 2; ++hh) {
            __syncthreads();
#pragma unroll
            for (int q = 0; q < 12; ++q) {
                const int cid = q * NTHREADS + tid, which = cid / 3072, rem = cid - which * 3072, col = rem >> 6, ch = rem & 63;
                const v4u val = *(const v4u*)(WRT + (size_t)which * 48 * 1024 + (size_t)col * D + hh * 512 + ch * 8);
                *(LAS v4u*)(Wl + which * 49152 + col * 1024 + ((ch ^ (col & 15)) << 4)) = val;
            }
            __syncthreads();
#pragma unroll 8
            for (int ks = 0; ks < 16; ++ks) {
                const bf16x8 fh = *(const bf16x8*)(ah + hh * 512 + 32 * ks);
#pragma unroll
                for (int ct = 0; ct < 3; ++ct) {
                    const LAS unsigned char* wp = Wl + (16 * ct + i) * 1024 + (((4 * ks + h) ^ i) << 4);
                    const bf16x8 wh = *(const LAS bf16x8*)wp, wl = *(const LAS bf16x8*)(wp + 49152);
                    acc[ct] = MFMA16(fh, wh, acc[ct]); acc[ct] = MFMA16(fh, wl, acc[ct]);
                }
            }
        }
        asm volatile("s_waitcnt lgkmcnt(0)" ::: "memory");
#pragma unroll
        for (int ct = 0; ct < 3; ++ct)
#pragma unroll
            for (int r = 0; r < 4; ++r) lg[(4 * h + r) * 52 + 16 * ct + i] = acc[ct][r];
        asm volatile("s_waitcnt lgkmcnt(0)" ::: "memory");
        if (lane < 16) {
            const float* L_ = lg + lane * 52;
            float lc[4];
#pragma unroll
            for (int o = 0; o < 4; ++o) lc[o] = L_[o] + p.b_coarse[o];
            int grp = 0; float mx = lc[0];
#pragma unroll
            for (int o = 1; o < 4; ++o) if (lc[o] > mx) { mx = lc[o]; grp = o; }
            float den = 0.f;
#pragma unroll
            for (int o = 0; o < 4; ++o) den += expf(lc[o] - mx);
            const float pg = 1.f / den;
            float f[8];
#pragma unroll
            for (int e = 0; e < 8; ++e) f[e] = L_[4 + grp * 8 + e] + p.b_fine[grp * 8 + e];
            int i1 = 0; float m1 = f[0];
#pragma unroll
            for (int e = 1; e < 8; ++e) if (f[e] > m1) { m1 = f[e]; i1 = e; }
            int i2 = 0; float m2 = -INFINITY;
#pragma unroll
            for (int e = 0; e < 8; ++e) if (e != i1 && f[e] > m2) { m2 = f[e]; i2 = e; }
            const float e2 = expf(m2 - m1);
            const float wa1 = pg / (1.f + e2), wa2 = pg * e2 / (1.f + e2);
            ex1 = grp * 8 + i1; ex2 = grp * 8 + i2; rw1 = wa1; rw2 = wa2;
        }
        }
        __syncthreads();
        int l1 = 0, l2 = 0;
        if (inr && lane < 16) { l1 = atomicAdd(&cntl[ex1], 1); l2 = atomicAdd(&cntl[ex2], 1); }
        __syncthreads();
        if (tid < 32) { const int c_ = cntl[tid]; cntl[32 + tid] = c_ ? atomicAdd(&CNT[tid], c_) : 0; }
        __syncthreads();
        if (inr && lane < 16) {
            const int t = tb + lane;
            const int s1 = cntl[32 + ex1] + l1, s2 = cntl[32 + ex2] + l2;
            LIST[(size_t)ex1 * T + s1] = 2 * t; WTS[2 * t] = rw1; ES[2 * t] = ex1 * 65536 + s1;
            LIST[(size_t)ex2 * T + s2] = 2 * t + 1; WTS[2 * t + 1] = rw2; ES[2 * t + 1] = ex2 * 65536 + s2;
        }
        __syncthreads();
    }
}

constexpr int NSA_NB = 3, NSA_DEPTH = 2;
constexpr int NSA_TB = 64 * 128;
constexpr int NSA_KOFF = 0, NSA_VOFF = NSA_NB * NSA_TB, NSA_WOFF = 2 * NSA_NB * NSA_TB;
constexpr int NSA_WST = 8448;
constexpr int NSA_ST = NSA_WOFF, NSA_STB = 272, NSA_QL = NSA_ST + 256 * NSA_STB, NSA_SELQ = NSA_QL + 32768, NSA_TASK = NSA_SELQ + 2048;
constexpr int NSA_ACT = NSA_TASK + 64, NSA_TL = NSA_TASK + 128, NSA_NCNT = NSA_TASK + 768, NSA_QLST = NSA_TASK + 1024;
static_assert(NSA_ST + 8 * NSA_WST <= NSA_QL && NSA_QLST + 128 * 64 <= 163840 - 64, "NSA LDS map");
__device__ __forceinline__ int nsa_fk(int r) { return ((r >> 3) & 3) | (((r >> 1) & 1) << 2); }
__device__ __forceinline__ int nsa_fv(int r) { return (r >> 1) & 7; }
__device__ __forceinline__ void softmax_fast(f32x4& x0, f32x4& x1, float& m, float& l, f32x4 (&o)[4]) {
    float tm = fmaxf(fmaxf(fmaxf(x0[0], x0[1]), fmaxf(x0[2], x0[3])), fmaxf(fmaxf(x1[0], x1[1]), fmaxf(x1[2], x1[3])));
    tm = hmax4(tm);
    const float mn = fmaxf(m, tm);
    const float alpha = __builtin_amdgcn_exp2f(m - mn);
    m = mn;
#pragma unroll
    for (int r = 0; r < 4; ++r) { x0[r] = __builtin_amdgcn_exp2f(x0[r] - mn); x1[r] = __builtin_amdgcn_exp2f(x1[r] - mn); }
    l = l * alpha + ((x0[0] + x0[1]) + (x0[2] + x0[3])) + ((x1[0] + x1[1]) + (x1[2] + x1[3]));
#pragma unroll
    for (int dt = 0; dt < 4; ++dt) o[dt] = o[dt] * alpha;
}
template <int MODE, bool FAST, int HM = 3, int FM = 0>
__device__ __forceinline__ void nsa_tile(unsigned char* ldsb, int buf, int tile, int i, int h, int t0, int sq, const bf16x8 (&qf)[2][2], const float (&slope2)[2],
                                         float (&m)[2], float (&l)[2], f32x4 (&acc)[2][4], const float (&invl)[2], bool bit, float* impw, int ncq, float& carry,
                                         f32x4 (&lacc)[2], float gapf) {
    const f32x4 z4 = {0.f, 0.f, 0.f, 0.f};
    const int q = i & 7, r2 = i >> 3, rk0 = 8 * (i >> 2) + (i & 3);
    constexpr bool LMFMA = (MODE == 2 || MODE == 3);
    const v4u ones_u = (i == 0) ? (v4u){0x3F803F80u, 0x3F803F80u, 0x3F803F80u, 0x3F803F80u} : (v4u){0u, 0u, 0u, 0u};
    const bf16x8 ones = __builtin_bit_cast(bf16x8, ones_u);
    if constexpr (LMFMA && FAST) {
        const int key00 = 64 * tile;
        const unsigned char* kbase = ldsb + NSA_KOFF + buf * NSA_TB; const unsigned char* vbase = ldsb + NSA_VOFF + buf * NSA_TB;
        const int dq0 = sq - (key00 + 8 * h);
        bf16x8 kfr[2][2][2];
#pragma unroll
        for (int hf = 0; hf < 2; ++hf) {
            const int ra = 32 * hf + rk0, rb = ra + 4;
            const unsigned char* ka_ = kbase + ra * 128; const unsigned char* kb2_ = kbase + rb * 128;
            const int fa = nsa_fk(ra), fb = nsa_fk(rb);
            kfr[hf][0][0] = *(const bf16x8*)(ka_ + ((h ^ fa) << 4)); kfr[hf][0][1] = *(const bf16x8*)(ka_ + (((4 + h) ^ fa) << 4));
            kfr[hf][1][0] = *(const bf16x8*)(kb2_ + ((h ^ fb) << 4)); kfr[hf][1][1] = *(const bf16x8*)(kb2_ + (((4 + h) ^ fb) << 4));
        }
#pragma unroll
        for (int tt = 0; tt < 2; ++tt) {
            const float shift = slope2[tt] * 64.f * gapf, alpha = __builtin_amdgcn_exp2f(-shift), mref = m[tt] + shift;
            m[tt] = mref;
            const float cbase = ((MODE == 2 && !bit) ? -1e30f : -slope2[tt] * (float)dq0 - mref);
            f32x4 x[2][2];
#pragma unroll
            for (int hf = 0; hf < 2; ++hf) {
                f32x4 c0, c1; const float bh = cbase + (float)(32 * hf) * slope2[tt];
#pragma unroll
                for (int rr = 0; rr < 4; ++rr) { c0[rr] = bh + slope2[tt] * (float)rr; c1[rr] = bh + slope2[tt] * (float)(4 + rr); }
                x[hf][0] = MFMA16(kfr[hf][0][0], qf[tt][0], c0); x[hf][0] = MFMA16(kfr[hf][0][1], qf[tt][1], x[hf][0]);
                x[hf][1] = MFMA16(kfr[hf][1][0], qf[tt][0], c1); x[hf][1] = MFMA16(kfr[hf][1][1], qf[tt][1], x[hf][1]);
            }
            bool big = false;
#pragma unroll
            for (int hf = 0; hf < 2; ++hf)
#pragma unroll
                for (int sb = 0; sb < 2; ++sb)
#pragma unroll
                    for (int rr = 0; rr < 4; ++rr) big |= x[hf][sb][rr] > 30.f;
            float asc = alpha;
            if (__builtin_expect(__any(big), 0)) {
                float tm = fmaxf(fmaxf(fmaxf(x[0][0][0], x[0][0][1]), fmaxf(x[0][0][2], x[0][0][3])), fmaxf(fmaxf(x[0][1][0], x[0][1][1]), fmaxf(x[0][1][2], x[0][1][3])));
                tm = fmaxf(tm, fmaxf(fmaxf(fmaxf(x[1][0][0], x[1][0][1]), fmaxf(x[1][0][2], x[1][0][3])), fmaxf(fmaxf(x[1][1][0], x[1][1][1]), fmaxf(x[1][1][2], x[1][1][3]))));
                tm = hmax4(tm);
                const float up = fmaxf(tm, 0.f);
#pragma unroll
                for (int hf = 0; hf < 2; ++hf)
#pragma unroll
                    for (int sb = 0; sb < 2; ++sb)
#pragma unroll
                        for (int rr = 0; rr < 4; ++rr) x[hf][sb][rr] -= up;
                m[tt] = mref + up; asc = alpha * __builtin_amdgcn_exp2f(-up);
            }
#pragma unroll
            for (int hf = 0; hf < 2; ++hf)
#pragma unroll
                for (int sb = 0; sb < 2; ++sb)
#pragma unroll
                    for (int rr = 0; rr < 4; ++rr) x[hf][sb][rr] = __builtin_amdgcn_exp2f(x[hf][sb][rr]);
#pragma unroll
            for (int dt = 0; dt < 4; ++dt) acc[tt][dt] = acc[tt][dt] * asc;
            lacc[tt] = lacc[tt] * asc;
#pragma unroll
            for (int hf = 0; hf < 2; ++hf) {
                const bf16x8 pf = pack_p(x[hf][0], x[hf][1]);
#pragma unroll
                for (int dt = 0; dt < 4; ++dt) { const int vr = 16 * dt + i; const bf16x8 vfr = *(const bf16x8*)(vbase + vr * 128 + (((4 * hf + h) ^ nsa_fv(vr)) << 4)); acc[tt][dt] = MFMA16(vfr, pf, acc[tt][dt]); }
                lacc[tt] = MFMA16(ones, pf, lacc[tt]);
            }
        }
        return;
    }
    {
            const int key00 = 64 * tile;
            const unsigned char* kbase = ldsb + NSA_KOFF + buf * NSA_TB; const unsigned char* vbase = ldsb + NSA_VOFF + buf * NSA_TB;
            constexpr bool fast = FAST;
            int dq0 = sq - (key00 + 8 * h);
            if (MODE == 4) dq0 += i;
            unsigned vm[2][2] = {{15u, 15u}, {15u, 15u}};
            if (!fast) {
#pragma unroll
                for (int hf = 0; hf < 2; ++hf) {
                    const int kb = key00 + 32 * hf + 8 * h, dq = dq0 - 32 * hf;
                    unsigned a0 = 0u, a1 = 0u;
#pragma unroll
                    for (int rr = 0; rr < 4; ++rr) {
                        bool ok0, ok1;
                        if (MODE <= 1) { ok0 = kb + rr < ncq; ok1 = kb + 4 + rr < ncq; }
                        else if (MODE == 2) { ok0 = bit && dq - rr >= 0; ok1 = bit && dq - 4 - rr >= 0; }
                        else if (MODE == 3) { ok0 = dq - rr >= 0 && dq - rr < 512; ok1 = dq - 4 - rr >= 0 && dq - 4 - rr < 512; }
                        else { ok0 = dq - rr >= 0 && dq - rr <= 128; ok1 = dq - 4 - rr >= 0 && dq - 4 - rr <= 128; }
                        a0 |= ok0 ? (1u << rr) : 0u; a1 |= ok1 ? (1u << rr) : 0u;
                    }
                    vm[hf][0] = a0; vm[hf][1] = a1;
                }
            }
            float Q4[2][2] = {{0.f, 0.f}, {0.f, 0.f}}, E3[2][2] = {{0.f, 0.f}, {0.f, 0.f}};
#pragma unroll
            for (int tt = 0; tt < 2; ++tt) {
                f32x4 x[2][2];
                if (MODE == 4 && tt == 1) {
                    dq0 += 16;
#pragma unroll
                    for (int hf = 0; hf < 2; ++hf) {
                        const int dq = dq0 - 32 * hf;
                        unsigned a0 = 0u, a1 = 0u;
#pragma unroll
                        for (int rr = 0; rr < 4; ++rr) { a0 |= (dq - rr >= 0 && dq - rr <= 128) ? (1u << rr) : 0u; a1 |= (dq - 4 - rr >= 0 && dq - 4 - rr <= 128) ? (1u << rr) : 0u; }
                        vm[hf][0] = a0; vm[hf][1] = a1;
                    }
                }
                const bool cinit = (MODE >= 2) && fast;
                const float cbase = cinit ? ((MODE == 2 && !bit) ? -1e30f : -slope2[tt] * (float)dq0) : 0.f;
#pragma unroll
                for (int hf = 0; hf < 2; ++hf) {
                    if (!((HM >> hf) & 1)) { x[hf][0] = (f32x4){-1e30f, -1e30f, -1e30f, -1e30f}; x[hf][1] = x[hf][0]; continue; }
                    const int ra = 32 * hf + rk0, rb = ra + 4;
                    const unsigned char* ka_ = kbase + ra * 128; const unsigned char* kb2_ = kbase + rb * 128;
                    const int fa = nsa_fk(ra), fb = nsa_fk(rb);
                    const bf16x8 k00 = *(const bf16x8*)(ka_ + ((h ^ fa) << 4)), k01 = *(const bf16x8*)(ka_ + (((4 + h) ^ fa) << 4));
                    const bf16x8 k10 = *(const bf16x8*)(kb2_ + ((h ^ fb) << 4)), k11 = *(const bf16x8*)(kb2_ + (((4 + h) ^ fb) << 4));
                    f32x4 c0 = z4, c1 = z4;
                    if (cinit) {
                        const float bh = cbase + (float)(32 * hf) * slope2[tt];
#pragma unroll
                        for (int rr = 0; rr < 4; ++rr) { c0[rr] = bh + slope2[tt] * (float)rr; c1[rr] = bh + slope2[tt] * (float)(4 + rr); }
                    } else if (MODE <= 1 && !fast) {
                        const float kbf = (float)(key00 + 32 * hf + 8 * h), ncf = (float)ncq;
#pragma unroll
                        for (int rr = 0; rr < 4; ++rr) { c0[rr] = kbf + (float)rr < ncf ? 0.f : -1e30f; c1[rr] = kbf + (float)(4 + rr) < ncf ? 0.f : -1e30f; }
                    } else if (MODE >= 3 && !fast) {
                        constexpr float MID = MODE == 3 ? 255.5f : 64.f;
                        const float dqf = (float)(dq0 - 32 * hf), bh = -slope2[tt] * dqf, ef = dqf - MID;
                        if ((FM >> hf) & 1) {
#pragma unroll
                            for (int rr = 0; rr < 4; ++rr) { c0[rr] = bh + slope2[tt] * (float)rr; c1[rr] = bh + slope2[tt] * (float)(4 + rr); }
                        } else {
#pragma unroll
                        for (int rr = 0; rr < 4; ++rr) {
                            c0[rr] = __builtin_fabsf(ef - (float)rr) <= MID ? bh + slope2[tt] * (float)rr : -1e30f;
                            c1[rr] = __builtin_fabsf(ef - (float)(4 + rr)) <= MID ? bh + slope2[tt] * (float)(4 + rr) : -1e30f;
                        }
                        }
                    } else if (MODE == 2) {
                        const float bh = -slope2[tt] * (float)(dq0 - 32 * hf);
#pragma unroll
                        for (int rr = 0; rr < 4; ++rr) { c0[rr] = ((vm[hf][0] >> rr) & 1u) ? bh + slope2[tt] * (float)rr : -1e30f; c1[rr] = ((vm[hf][1] >> rr) & 1u) ? bh + slope2[tt] * (float)(4 + rr) : -1e30f; }
                    }
                    x[hf][0] = MFMA16(k00, qf[tt][0], c0); x[hf][0] = MFMA16(k01, qf[tt][1], x[hf][0]);
                    x[hf][1] = MFMA16(k10, qf[tt][0], c1); x[hf][1] = MFMA16(k11, qf[tt][1], x[hf][1]);
                }
                if (MODE <= 1) {
                    static_assert(QK_C == 1.0f, "the compressed-branch scores leave the MFMA final (q is pre-scaled, the mask came in through C)");
                } else {
                }
                if (MODE != 1) {
                    float tm = fmaxf(fmaxf(fmaxf(x[0][0][0], x[0][0][1]), fmaxf(x[0][0][2], x[0][0][3])), fmaxf(fmaxf(x[0][1][0], x[0][1][1]), fmaxf(x[0][1][2], x[0][1][3])));
                    tm = fmaxf(tm, fmaxf(fmaxf(fmaxf(x[1][0][0], x[1][0][1]), fmaxf(x[1][0][2], x[1][0][3])), fmaxf(fmaxf(x[1][1][0], x[1][1][1]), fmaxf(x[1][1][2], x[1][1][3]))));
                    tm = hmax4(tm);
                    const float mn = fmaxf(m[tt], tm), alpha = __builtin_amdgcn_exp2f(m[tt] - mn);
                    m[tt] = mn;
                    const float mnc = fmaxf(mn, -1e29f);
                    float sum = 0.f;
#pragma unroll
                    for (int hf = 0; hf < 2; ++hf)
#pragma unroll
                        for (int sb = 0; sb < 2; ++sb) {
                            if (!((HM >> hf) & 1)) { x[hf][sb] = z4; continue; }
#pragma unroll
                            for (int rr = 0; rr < 4; ++rr) {
                                x[hf][sb][rr] = __builtin_amdgcn_exp2f(x[hf][sb][rr] - mnc);
                                sum += x[hf][sb][rr];
                            }
                        }
                    if (LMFMA) lacc[tt] = lacc[tt] * alpha; else l[tt] = l[tt] * alpha + sum;
                    if (MODE != 0) {
#pragma unroll
                        for (int dt = 0; dt < 4; ++dt) acc[tt][dt] = acc[tt][dt] * alpha;
                    }
                } else {
                    const float mm = m[tt], il = invl[tt];
#pragma unroll
                    for (int hf = 0; hf < 2; ++hf)
#pragma unroll
                        for (int sb = 0; sb < 2; ++sb) {
#pragma unroll
                            for (int rr = 0; rr < 4; ++rr) {
                                x[hf][sb][rr] = __builtin_amdgcn_exp2f(x[hf][sb][rr] - mm) * il;
                            }
                            Q4[hf][sb] += (x[hf][sb][0] + x[hf][sb][1]) + (x[hf][sb][2] + x[hf][sb][3]); E3[hf][sb] += x[hf][sb][3];
                        }
                }
                if (MODE != 0) {
#pragma unroll
                    for (int hf = 0; hf < 2; ++hf) {
                        if (!((HM >> hf) & 1)) continue;
                        const bf16x8 pf = pack_p(x[hf][0], x[hf][1]);
#pragma unroll
                        for (int dt = 0; dt < 4; ++dt) { const int vr = 16 * dt + i; const bf16x8 vfr = *(const bf16x8*)(vbase + vr * 128 + (((4 * hf + h) ^ nsa_fv(vr)) << 4)); acc[tt][dt] = MFMA16(vfr, pf, acc[tt][dt]); }
                        if (LMFMA) lacc[tt] = MFMA16(ones, pf, lacc[tt]);
                    }
                }
            }
            if (MODE == 1) {
#pragma unroll
                for (int hf = 0; hf < 2; ++hf) {
                    float Q4a = Q4[hf][0], Q4b = Q4[hf][1], E3a = E3[hf][0], E3b = E3[hf][1];
                    Q4a += __shfl_xor(Q4a, 8); Q4b += __shfl_xor(Q4b, 8); E3a += __shfl_xor(E3a, 8); E3b += __shfl_xor(E3b, 8);
                    float prevE = __shfl_up(E3b, 16);
                    if (h == 0) prevE = carry;
                    carry = __shfl(E3b, i + 48);
                    const int key0 = key00 + 32 * hf;
                    if (r2 == 0) { impw[q * 132 + (key0 >> 2) + 2 * h] = Q4a + prevE; impw[q * 132 + (key0 >> 2) + 2 * h + 1] = Q4b + E3a; }
                }
            }
            }
}
template <int MODE>
__device__ __forceinline__ void nsa_branch(unsigned char* ldsb, const bf16_t* Kg, const bf16_t* VTg, size_t vstride, int tile_lo, int tile_hi,
                                           int tid, int i, int h, int t0, int sq, const bf16x8 (&qf)[2][2], const float (&slope2)[2],
                                           float (&m)[2], float (&l)[2], f32x4 (&acc)[2][4], const float (&invl)[2],
                                           unsigned sel0, unsigned sel1, unsigned sel2, unsigned sel3, float* impw, int ncq, f32x4 (&lacc)[2]) {
    const f32x4 z4 = {0.f, 0.f, 0.f, 0.f};
    int last_tile = -1;
    const int q = i & 7, r2 = i >> 3, lane = tid & 63, wv = __builtin_amdgcn_readfirstlane(tid >> 6);
    const int srow = 8 * wv + (lane >> 3), pch = lane & 7;
    const bf16_t* gk = Kg + (size_t)srow * 64 + ((pch ^ nsa_fk(srow)) << 3);
    const bf16_t* gv = VTg + (size_t)srow * vstride + ((pch ^ nsa_fv(srow)) << 3);
    const unsigned ldsK = (unsigned)(uintptr_t)(ldsb + NSA_KOFF) + wv * 1024u, ldsV = (unsigned)(uintptr_t)(ldsb + NSA_VOFF) + wv * 1024u;
#define NSA_DMA(tile_, buf_) do { \
        __builtin_amdgcn_global_load_lds((const unsigned*)(gk + (size_t)(tile_) * 64 * 64), (PG8_LAS unsigned*)(uintptr_t)__builtin_amdgcn_readfirstlane((int)(ldsK + (buf_) * NSA_TB)), 16, 0, 0); \
        if (MODE != 0) __builtin_amdgcn_global_load_lds((const unsigned*)(gv + (size_t)(tile_) * 64), (PG8_LAS unsigned*)(uintptr_t)__builtin_amdgcn_readfirstlane((int)(ldsV + (buf_) * NSA_TB)), 16, 0, 0); } while (0)
    const int rk0 = 8 * (i >> 2) + (i & 3);
    if (tile_lo > tile_hi) return;
#pragma unroll
    for (int d = 0; d < NSA_DEPTH; ++d) if (tile_lo + d <= tile_hi) NSA_DMA(tile_lo + d, d);
    int buf = 0; float carry = 0.f;
    const int ncmin = (MODE <= 1) ? (t0 >= 31 ? ((t0 - 31) >> 4) + 1 : 0) : 0, ncmaxw = (MODE <= 1) ? (t0 + 7 >= 31 ? ((t0 + 7 - 31) >> 4) + 1 : 0) : 0;
#pragma unroll 1
    for (int tile = tile_lo; tile <= tile_hi; ++tile) {
        {
            {
        if (MODE != 0) { if (tile + 1 <= tile_hi) asm volatile("s_waitcnt vmcnt(2)" ::: "memory"); else asm volatile("s_waitcnt vmcnt(0)" ::: "memory"); }
        else { if (tile + 1 <= tile_hi) asm volatile("s_waitcnt vmcnt(1)" ::: "memory"); else asm volatile("s_waitcnt vmcnt(0)" ::: "memory"); }
        asm volatile("s_waitcnt lgkmcnt(0)" ::: "memory");
        __builtin_amdgcn_s_barrier();
        asm volatile("" ::: "memory");
        if (tile + NSA_DEPTH <= tile_hi) { const int nb_ = (buf + NSA_DEPTH) % NSA_NB; NSA_DMA(tile + NSA_DEPTH, nb_); }
        bool active = true, bit = true;
        if (MODE == 2) { const int w = tile >> 5; const unsigned sw = w == 0 ? sel0 : (w == 1 ? sel1 : (w == 2 ? sel2 : sel3)); bit = (sw >> (tile & 31)) & 1u; active = __any(bit); }
        if (MODE <= 1) active = 64 * tile < ncmaxw;
        if (MODE == 3) active = (64 * tile + 63 > t0 - 512);
        if (MODE == 4) active = (64 * tile + 63 >= t0 - 128) && (64 * tile <= t0 + 31);
        if (active) {
            const int key00_ = 64 * tile;
            bool fast;
            if (MODE <= 1) fast = key00_ + 63 < ncmin; else if (MODE == 2) fast = key00_ + 63 <= t0; else if (MODE == 3) fast = (key00_ + 63 <= t0) && (t0 + 7 - key00_ < 512); else fast = (key00_ + 63 <= t0) && (t0 + 31 - key00_ <= 128);
            if ((MODE == 2 || MODE == 3) && (last_tile < 0 || __any(m[0] < -1e29f || m[1] < -1e29f))) fast = false;
            const float gapf = (float)(tile - last_tile);
            if (fast) nsa_tile<MODE, true>(ldsb, buf, tile, i, h, t0, sq, qf, slope2, m, l, acc, invl, bit, impw, ncq, carry, lacc, gapf);
            else if (MODE <= 1 && key00_ + 32 >= ncmaxw) nsa_tile<MODE, false, 1>(ldsb, buf, tile, i, h, t0, sq, qf, slope2, m, l, acc, invl, bit, impw, ncq, carry, lacc, gapf);
            else if (MODE == 3) {
                const bool h0 = (key00_ + 31 >= t0 - 511) && (key00_ <= t0 + 7), h1 = (key00_ + 63 >= t0 - 511) && (key00_ + 32 <= t0 + 7);
                if (h0 && h1) {
                    const bool f0 = (key00_ + 31 <= t0) && (t0 + 7 - key00_ <= 511), f1 = (key00_ + 63 <= t0) && (t0 + 7 - (key00_ + 32) <= 511);
                    if (f1 && !f0) nsa_tile<MODE, false, 3, 2>(ldsb, buf, tile, i, h, t0, sq, qf, slope2, m, l, acc, invl, bit, impw, ncq, carry, lacc, gapf);
                    else if (f0 && !f1) nsa_tile<MODE, false, 3, 1>(ldsb, buf, tile, i, h, t0, sq, qf, slope2, m, l, acc, invl, bit, impw, ncq, carry, lacc, gapf);
                    else nsa_tile<MODE, false, 3>(ldsb, buf, tile, i, h, t0, sq, qf, slope2, m, l, acc, invl, bit, impw, ncq, carry, lacc, gapf);
                }
                else if (h0) nsa_tile<MODE, false, 1>(ldsb, buf, tile, i, h, t0, sq, qf, slope2, m, l, acc, invl, bit, impw, ncq, carry, lacc, gapf);
                else nsa_tile<MODE, false, 2>(ldsb, buf, tile, i, h, t0, sq, qf, slope2, m, l, acc, invl, bit, impw, ncq, carry, lacc, gapf);
            }
            else if (MODE == 4) {
                const bool h0 = (key00_ + 31 >= t0 - 128) && (key00_ <= t0 + 31), h1 = (key00_ + 63 >= t0 - 128) && (key00_ + 32 <= t0 + 31);
                if (h0 && h1) {
                    const bool f0 = (key00_ + 31 <= t0) && (t0 + 31 - key00_ <= 128), f1 = (key00_ + 63 <= t0) && (t0 + 31 - (key00_ + 32) <= 128);
                    if (f1 && !f0) nsa_tile<MODE, false, 3, 2>(ldsb, buf, tile, i, h, t0, sq, qf, slope2, m, l, acc, invl, bit, impw, ncq, carry, lacc, gapf);
                    else if (f0 && !f1) nsa_tile<MODE, false, 3, 1>(ldsb, buf, tile, i, h, t0, sq, qf, slope2, m, l, acc, invl, bit, impw, ncq, carry, lacc, gapf);
                    else nsa_tile<MODE, false, 3>(ldsb, buf, tile, i, h, t0, sq, qf, slope2, m, l, acc, invl, bit, impw, ncq, carry, lacc, gapf);
                }
                else if (h0) nsa_tile<MODE, false, 1>(ldsb, buf, tile, i, h, t0, sq, qf, slope2, m, l, acc, invl, bit, impw, ncq, carry, lacc, gapf);
                else nsa_tile<MODE, false, 2>(ldsb, buf, tile, i, h, t0, sq, qf, slope2, m, l, acc, invl, bit, impw, ncq, carry, lacc, gapf);
            }
            else nsa_tile<MODE, false>(ldsb, buf, tile, i, h, t0, sq, qf, slope2, m, l, acc, invl, bit, impw, ncq, carry, lacc, gapf);
            last_tile = tile;
        }
        buf = (buf + 1) % NSA_NB;
            }
        }
    }
    asm volatile("s_waitcnt lgkmcnt(0)" ::: "memory");
    __builtin_amdgcn_s_barrier();
    asm volatile("" ::: "memory");
#undef NSA_DMA
}

__device__ __forceinline__ void ph_dilated2(const Params& p, unsigned char* ldsb) {
    const int tid0 = opq_tid(p.wbase);
    unsigned char* ws = p.ws;
    const bf16_t* QA = (const bf16_t*)(ws + O_QA); const bf16_t* KA = (const bf16_t*)(ws + O_KA); const bf16_t* VAT = (const bf16_t*)(ws + O_VAT);
    bf16_t* OG = (bf16_t*)(ws + O_OG); float* LSE = (float*)(ws + O_LSE);
    int* ctr = (int*)(ws + O_CNT) + 66;
    volatile int* tword = (volatile int*)(ldsb + NSA_TASK);
    for (;;) {
        int tid = tid0; asm volatile("" : "+v"(tid));
        const int lane = tid & 63, wv = __builtin_amdgcn_readfirstlane(tid >> 6), i = lane & 15, h = lane >> 4;
        if (tid == 0) *tword = atomicAdd(ctr, 1);
        __syncthreads();
        const int task = __builtin_amdgcn_readfirstlane(*tword);
        __syncthreads();
        if (task >= NB * 12 * (S / 256)) break;
        int g, qb, idx;
        if (task < 384) { g = 0; qb = 31 - (task >> 4); idx = task & 15; }
        else if (task < 864) { const int t1 = task - 384, c = 8 - t1 / 80, r = t1 % 80;
            if (r < 16) { g = 0; qb = c - 1; idx = r; } else { g = 1; qb = (c - 1) + 8 * ((r - 16) >> 4); idx = (r - 16) & 15; } }
        else { const int t2 = task - 864, c = 2 - t2 / 336, r = t2 % 336;
            if (r < 16) { g = 0; qb = c - 1; idx = r; } else if (r < 80) { g = 1; qb = (c - 1) + 8 * ((r - 16) >> 4); idx = (r - 16) & 15; } else { g = 2; qb = (c - 1) + 2 * ((r - 80) >> 4); idx = (r - 80) & 15; } }
        const int b = idx >> 2, hd = idx & 3, bgh = b * 12 + g * 4 + hd;
        const int sh = 2 * g, d = 1 << sh, L = S >> sh, P0 = qb * 256, r = P0 / L, l0b = P0 - r * L, l0 = l0b + 32 * wv;
        float slope2[2]; slope2[0] = slope2[1] = exp2f(-8.0f * (float)(g * 4 + hd + 1) / 12.0f) * LOG2E * (float)d;
        const size_t base = (size_t)bgh;
        const bf16_t* Qp = QA + (base * S + (size_t)r * L + l0) * 64;
        bf16x8 qf[2][2];
#pragma unroll
        for (int qt = 0; qt < 2; ++qt) { qf[qt][0] = *(const bf16x8*)(Qp + (size_t)(qt * 16 + i) * 64 + 8 * h); qf[qt][1] = *(const bf16x8*)(Qp + (size_t)(qt * 16 + i) * 64 + 8 * h + 32); }
        float m[2] = {-1e30f, -1e30f}, l[2] = {0.f, 0.f}, invl[2] = {0.f, 0.f};
        f32x4 acc[2][4], lacc[2] = {{0.f, 0.f, 0.f, 0.f}, {0.f, 0.f, 0.f, 0.f}};
#pragma unroll
        for (int qt = 0; qt < 2; ++qt)
#pragma unroll
            for (int dt = 0; dt < 4; ++dt) acc[qt][dt] = (f32x4){0.f, 0.f, 0.f, 0.f};
        const int tlo = l0b >= 128 ? (l0b - 128) >> 6 : 0, thi = (l0b + 255) >> 6;
        nsa_branch<4>(ldsb, KA + (base * S + (size_t)r * L) * 64, VAT + (base * 64) * S + (size_t)r * L, S, tlo, thi, tid, i, h, l0, l0, qf, slope2, m, l, acc, invl, 0u, 0u, 0u, 0u, nullptr, 0, lacc);
#pragma unroll
        for (int qt = 0; qt < 2; ++qt) {
            float lt = l[qt]; lt = hsum4(lt);
            const float inv = 1.f / lt;
            const int sp = (l0 + qt * 16 + i) * d + r;
            const size_t t = (size_t)b * S + sp;
            bf16_t* op = OG + (t * 3 + g) * 256 + hd * 64 + 4 * h;
#pragma unroll
            for (int dt = 0; dt < 4; ++dt) {
                const f32x4 v = acc[qt][dt] * inv;
                uint2 w; w.x = pg8::cvt_pk_bf16(v[0], v[1]); w.y = pg8::cvt_pk_bf16(v[2], v[3]);
                *(uint2*)(op + 16 * dt) = w;
            }
            if (h == 0) LSE[t * 12 + g * 4 + hd] = (m[qt] + log2f(lt)) * LN2;
        }
    }
}

__device__ __forceinline__ void nsa_slc_gather(unsigned char* ldsb, const bf16_t* Kg, const bf16_t* VTg, int qblk, int tid, int i, int h, int t0b, int g) {
    const f32x4 z4 = {0.f, 0.f, 0.f, 0.f};
    LAS unsigned char* L_ = (LAS unsigned char*)ldsb;
    const int lane = tid & 63, wv = __builtin_amdgcn_readfirstlane(tid >> 6);
    const int srow = 8 * wv + (lane >> 3), pch = lane & 7;
    const bf16_t* gk = Kg + (size_t)srow * 64 + ((pch ^ nsa_fk(srow)) << 3);
    const bf16_t* gv = VTg + (size_t)srow * S + ((pch ^ nsa_fv(srow)) << 3);
    const unsigned ldsK = (unsigned)(uintptr_t)(ldsb + NSA_KOFF) + wv * 1024u, ldsV = (unsigned)(uintptr_t)(ldsb + NSA_VOFF) + wv * 1024u;
#define SLC_DMA(tile_, buf_) do { \
        __builtin_amdgcn_global_load_lds((const unsigned*)(gk + (size_t)(tile_) * 64 * 64), (PG8_LAS unsigned*)(uintptr_t)__builtin_amdgcn_readfirstlane((int)(ldsK + (buf_) * NSA_TB)), 16, 0, 0); \
        __builtin_amdgcn_global_load_lds((const unsigned*)(gv + (size_t)(tile_) * 64), (PG8_LAS unsigned*)(uintptr_t)__builtin_amdgcn_readfirstlane((int)(ldsV + (buf_) * NSA_TB)), 16, 0, 0); } while (0)
    const LAS unsigned char* QLST = (const LAS unsigned char*)(L_ + NSA_QLST);
    const int rk0 = 8 * (i >> 2) + (i & 3), head = i >> 2;
    const float slope = exp2f(-(float)(g * 4 + head + 1)) * LOG2E;
    const v4u ones_u = (i == 0) ? (v4u){0x3F803F80u, 0x3F803F80u, 0x3F803F80u, 0x3F803F80u} : (v4u){0u, 0u, 0u, 0u};
    const bf16x8 ones = __builtin_bit_cast(bf16x8, ones_u);
    const unsigned long long ltmask = (lane == 0) ? 0ull : (~0ull >> (64 - lane));
    LAS int* TL = (LAS int*)(L_ + NSA_TL);
    int nt;
    {
        const LAS unsigned* ACT = (const LAS unsigned*)(L_ + NSA_ACT); const LAS unsigned char* NC = (const LAS unsigned char*)(L_ + NSA_NCNT);
        const unsigned a0 = __builtin_amdgcn_readfirstlane(ACT[0] | (ACT[1] << 16)), a1 = __builtin_amdgcn_readfirstlane(ACT[2] | (ACT[3] << 16));
        const unsigned a2 = __builtin_amdgcn_readfirstlane(ACT[4] | (ACT[5] << 16)), a3 = __builtin_amdgcn_readfirstlane(ACT[6] | (ACT[7] << 16));
        const unsigned long long mlo = (unsigned long long)a0 | ((unsigned long long)a1 << 32), mhi = (unsigned long long)a2 | ((unsigned long long)a3 << 32);
        const int nlo = __popcll(mlo);
        nt = nlo + __popcll(mhi);
        const int n0 = NC[lane], n1 = NC[64 + lane];
        if ((mlo >> lane) & 1ull) TL[__popcll(mlo & ltmask)] = lane | (n0 << 8);
        if ((mhi >> lane) & 1ull) TL[nlo + __popcll(mhi & ltmask)] = (64 + lane) | (n1 << 8);
        asm volatile("s_waitcnt lgkmcnt(0)" ::: "memory");
    }
    int ta = __builtin_amdgcn_readfirstlane(TL[0]), tb = __builtin_amdgcn_readfirstlane(TL[1]), tc = __builtin_amdgcn_readfirstlane(TL[2]);
    if (0 < nt) SLC_DMA(ta & 255, 0);
    if (1 < nt) SLC_DMA(tb & 255, 1);
    int buf = 0;
#pragma unroll 1
    for (int kt = 0; kt < nt; ++kt) {
        if (kt + 1 < nt) asm volatile("s_waitcnt vmcnt(2)" ::: "memory"); else asm volatile("s_waitcnt vmcnt(0)" ::: "memory");
        asm volatile("s_waitcnt lgkmcnt(0)" ::: "memory");
        __builtin_amdgcn_s_barrier();
        asm volatile("" ::: "memory");
        if (kt + 2 < nt) { const int nb_ = (buf + 2) % NSA_NB; SLC_DMA(tc & 255, nb_); }
        const int tdv = TL[(kt + 3) & 127];
        const int tile = ta & 255, n = ta >> 8, nct = (n + 3) >> 2;
        const LAS unsigned char* kbase = L_ + NSA_KOFF + buf * NSA_TB; const LAS unsigned char* vbase = L_ + NSA_VOFF + buf * NSA_TB;
        const int key00 = 64 * tile;
        const bool diag = tile == qblk;
#pragma unroll 1
        for (int c = wv; c < nct; c += NWAVES) {
            const int k = 4 * c + (i & 3); const bool valid = k < n;
            const int q6 = QLST[tile * 64 + (valid ? k : 0)];
            bf16x8 kf[2][4];
#pragma unroll
            for (int hf = 0; hf < 2; ++hf) {
                const int ra = 32 * hf + rk0, rb = ra + 4;
                const LAS unsigned char* ka_ = kbase + ra * 128; const LAS unsigned char* kb2_ = kbase + rb * 128;
                const int fa = nsa_fk(ra), fb = nsa_fk(rb);
                kf[hf][0] = *(const LAS bf16x8*)(ka_ + ((h ^ fa) << 4)); kf[hf][1] = *(const LAS bf16x8*)(ka_ + (((4 + h) ^ fa) << 4));
                kf[hf][2] = *(const LAS bf16x8*)(kb2_ + ((h ^ fb) << 4)); kf[hf][3] = *(const LAS bf16x8*)(kb2_ + (((4 + h) ^ fb) << 4));
            }
            asm volatile("" ::: "memory");
            const int col = q6 * 4 + head, sqc = t0b + q6;
            const LAS unsigned char* qrow = L_ + NSA_QL + col * 128; const int qsw = col & 7;
            const bf16x8 qf0 = *(const LAS bf16x8*)(qrow + ((h ^ qsw) << 4)), qf1 = *(const LAS bf16x8*)(qrow + (((4 + h) ^ qsw) << 4));
            LAS float* st = (LAS float*)(L_ + NSA_ST + col * NSA_STB);
            f32x4 acc[4];
#pragma unroll
            for (int dt = 0; dt < 4; ++dt) acc[dt] = *(const LAS f32x4*)(st + 16 * dt + 4 * h);
            const float m = st[64];
            f32x4 lacc = z4; if (h == 0) lacc[0] = st[65];
            asm volatile("" ::: "memory");
            const int dq0 = sqc - (key00 + 8 * h);
            f32x4 x[2][2];
#pragma unroll
            for (int hf = 0; hf < 2; ++hf) {
                f32x4 c0, c1; const float bh = -slope * (float)(dq0 - 32 * hf);
#pragma unroll
                for (int rr = 0; rr < 4; ++rr) { c0[rr] = bh + slope * (float)rr; c1[rr] = bh + slope * (float)(4 + rr); }
                x[hf][0] = MFMA16(kf[hf][0], qf0, c0); x[hf][0] = MFMA16(kf[hf][1], qf1, x[hf][0]);
                x[hf][1] = MFMA16(kf[hf][2], qf0, c1); x[hf][1] = MFMA16(kf[hf][3], qf1, x[hf][1]);
            }
            bf16x8 vf[2][4];
#pragma unroll
            for (int hf = 0; hf < 2; ++hf)
#pragma unroll
                for (int dt = 0; dt < 4; ++dt) { const int vr = 16 * dt + i; vf[hf][dt] = *(const LAS bf16x8*)(vbase + vr * 128 + (((4 * hf + h) ^ nsa_fv(vr)) << 4)); }
            asm volatile("" ::: "memory");
            if (diag) {
#pragma unroll
                for (int hf = 0; hf < 2; ++hf)
#pragma unroll
                    for (int sb = 0; sb < 2; ++sb)
#pragma unroll
                        for (int rr = 0; rr < 4; ++rr) if (dq0 - 32 * hf - 4 * sb - rr < 0) x[hf][sb][rr] = -1e30f;
            }
            float tm = fmaxf(fmaxf(fmaxf(x[0][0][0], x[0][0][1]), fmaxf(x[0][0][2], x[0][0][3])), fmaxf(fmaxf(x[0][1][0], x[0][1][1]), fmaxf(x[0][1][2], x[0][1][3])));
            tm = fmaxf(tm, fmaxf(fmaxf(fmaxf(x[1][0][0], x[1][0][1]), fmaxf(x[1][0][2], x[1][0][3])), fmaxf(fmaxf(x[1][1][0], x[1][1][1]), fmaxf(x[1][1][2], x[1][1][3]))));
            tm = hmax4(tm);
            const float mn = fmaxf(m, tm), alpha = __builtin_amdgcn_exp2f(m - mn);
#pragma unroll
            for (int hf = 0; hf < 2; ++hf)
#pragma unroll
                for (int sb = 0; sb < 2; ++sb)
#pragma unroll
                    for (int rr = 0; rr < 4; ++rr) x[hf][sb][rr] = __builtin_amdgcn_exp2f(x[hf][sb][rr] - mn);
#pragma unroll
            for (int dt = 0; dt < 4; ++dt) acc[dt] = acc[dt] * alpha;
            lacc = lacc * alpha;
#pragma unroll
            for (int hf = 0; hf < 2; ++hf) {
                const bf16x8 pf = pack_p(x[hf][0], x[hf][1]);
#pragma unroll
                for (int dt = 0; dt < 4; ++dt) acc[dt] = MFMA16(vf[hf][dt], pf, acc[dt]);
                lacc = MFMA16(ones, pf, lacc);
            }
            if (valid) {
#pragma unroll
                for (int dt = 0; dt < 4; ++dt) *(LAS f32x4*)(st + 16 * dt + 4 * h) = acc[dt];
                if (h == 0) { st[64] = mn; st[65] = lacc[0]; }
            }
        }
        ta = tb; tb = tc; tc = __builtin_amdgcn_readfirstlane(tdv);
        buf = (buf + 1) % NSA_NB;
    }
    asm volatile("s_waitcnt lgkmcnt(0)" ::: "memory");
    __builtin_amdgcn_s_barrier();
    asm volatile("" ::: "memory");
#undef SLC_DMA
}
__device__ __forceinline__ void ph_nsa2(const Params& p, unsigned char* ldsb) {
    const int tid0 = opq_tid(p.wbase);
    unsigned char* ws = p.ws;
    const bf16_t* BQ = (const bf16_t*)(ws + O_BQ); const float* BG = (const float*)(ws + O_BG); bf16_t* YB = (bf16_t*)(ws + O_YAB) + 256;
    const int bg = opq_bid() & 7;
    int* ctr = (int*)(ws + O_CNT) + 96 + bg;
    volatile int* tword = (volatile int*)(ldsb + NSA_TASK);
    int nxt_task = 0; if (tid0 == 0) nxt_task = atomicAdd(ctr, 1);
    for (;;) {
        int tid = tid0; asm volatile("" : "+v"(tid));
        const int lane = tid & 63, wv = __builtin_amdgcn_readfirstlane(tid >> 6), i = lane & 15, h = lane >> 4, q = i & 7, r2 = i >> 3;
        if (tid == 0) *tword = nxt_task;
        __syncthreads();
        const int task = __builtin_amdgcn_readfirstlane(*tword);
        if (tid < 8) ((unsigned*)(ldsb + NSA_ACT))[tid] = 0u;
        __syncthreads();
        if (task >= S / 64) break;
        if (tid == 0) nxt_task = atomicAdd(ctr, 1);
        const int qblk = (S / 64 - 1) - task, b = bg >> 1, g = bg & 1, t0b = qblk * 64, t0 = t0b + 8 * wv, sq = t0 + q;
        const int tq = b * S + sq;
        float* impw = (float*)(ldsb + NSA_WOFF + wv * NSA_WST); unsigned* selw = (unsigned*)(ldsb + NSA_WOFF + wv * NSA_WST + 8192);
        float* otl = (float*)(ldsb + NSA_WOFF + wv * NSA_WST) + lane;
#pragma unroll
        for (int k = 0; k < 17; ++k) if (lane + 64 * k < 1056) impw[lane + 64 * k] = 0.f;
        {
            const bf16_t* qsrc = BQ + ((size_t)b * S + t0b) * 512 + g * 256;
#pragma unroll
            for (int k = 0; k < 4; ++k) {
                const int row = 8 * (4 * wv + k) + (lane >> 3), pc = lane & 7, lc = pc ^ (row & 7);
                __builtin_amdgcn_global_load_lds((const unsigned*)(qsrc + (size_t)(row >> 2) * 512 + (row & 3) * 64 + lc * 8), (PG8_LAS unsigned*)(uintptr_t)__builtin_amdgcn_readfirstlane((int)((unsigned)(uintptr_t)(ldsb + NSA_QL) + (4 * wv + k) * 1024)), 16, 0, 0);
            }
        }
        float gate[2][3];
#pragma unroll
        for (int tt = 0; tt < 2; ++tt)
#pragma unroll
            for (int k = 0; k < 3; ++k) gate[tt][k] = BG[(size_t)tq * 24 + g * 12 + (2 * tt + r2) * 3 + k];
        bf16x8 qf[2][2]; float slope2[2];
#pragma unroll
        for (int tt = 0; tt < 2; ++tt) {
            const bf16_t* qp = BQ + (size_t)tq * 512 + g * 256 + (2 * tt + r2) * 64 + 8 * h;
            qf[tt][0] = *(const bf16x8*)qp; qf[tt][1] = *(const bf16x8*)(qp + 32);
            slope2[tt] = exp2f(-(float)(g * 4 + 2 * tt + r2 + 1)) * LOG2E;
        }
        const f32x4 z4 = {0.f, 0.f, 0.f, 0.f};
        f32x4 acc[2][4], lacc[2] = {{0.f, 0.f, 0.f, 0.f}, {0.f, 0.f, 0.f, 0.f}};
        float m[2], l[2], invl[2] = {0.f, 0.f};
        const int ncq = sq >= 31 ? ((sq - 31) >> 4) + 1 : 0;
        const int ncblk = (t0b + 63 >= 31) ? ((t0b + 63 - 31) >> 4) + 1 : 0;
        const int ctile_hi = ((ncblk + 63) >> 6) - 1;
        const bf16_t* Kc = (const bf16_t*)(ws + O_KC) + (size_t)bg * 512 * 64; const bf16_t* VcT = (const bf16_t*)(ws + O_VCT) + (size_t)bg * 64 * 512;
        m[0] = m[1] = -1e30f; l[0] = l[1] = 0.f;
        nsa_branch<0>(ldsb, Kc, VcT, 512, 0, ctile_hi, tid, i, h, t0, sq, qf, slope2, m, l, acc, invl, 0u, 0u, 0u, 0u, impw, ncq, lacc);
#pragma unroll
        for (int tt = 0; tt < 2; ++tt) { float lt = l[tt]; lt = hsum4(lt); invl[tt] = lt > 0.f ? 1.f / lt : 0.f; }
#pragma unroll
        for (int tt = 0; tt < 2; ++tt)
#pragma unroll
            for (int dt = 0; dt < 4; ++dt) acc[tt][dt] = z4;
        nsa_branch<1>(ldsb, Kc, VcT, 512, 0, ctile_hi, tid, i, h, t0, sq, qf, slope2, m, l, acc, invl, 0u, 0u, 0u, 0u, impw, ncq, lacc);
        unsigned sel0, sel1, sel2, sel3;
        {
            asm volatile("s_waitcnt lgkmcnt(0)" ::: "memory");
            const int qq = lane & 7, jq = lane >> 3, cur = (t0 + qq) >> 6;
            unsigned key[16];
#pragma unroll
            for (int jj = 0; jj < 16; ++jj) {
                const int j = jq * 16 + jj;
                const float sc = impw[qq * 132 + j] + ((j == 0 || j == cur || j == cur - 1) ? 1e4f : 0.f);
                key[jj] = (j <= cur) ? __float_as_uint(sc) : 0u;
            }
            unsigned tau = 0u; bool exact = false;
#pragma unroll 1
            for (int bit = 30; bit >= 0; --bit) {
                const unsigned cand = tau | (1u << bit);
                int cnt = 0;
#pragma unroll
                for (int jj = 0; jj < 16; ++jj) cnt += key[jj] >= cand ? 1 : 0;
                cnt += __builtin_amdgcn_update_dpp(0, cnt, 0x128, 0xf, 0xf, false);
                cnt = isum_h4(cnt);
                if (cnt >= 16) { tau = cand; exact = cnt == 16; }
                if (__all(exact)) break;
            }
            unsigned mk = 0u;
#pragma unroll
            for (int jj = 0; jj < 16; ++jj) mk |= (key[jj] >= tau && key[jj] != 0u) ? (1u << jj) : 0u;
            ((unsigned*)(ldsb + NSA_SELQ))[(8 * wv + qq) * 8 + jq] = mk;
            atomicOr((unsigned*)(ldsb + NSA_ACT) + jq, mk);
            sel0 = sel1 = sel2 = sel3 = 0u;
        }
        f32x4 oc[2][4];
#pragma unroll
        for (int tt = 0; tt < 2; ++tt) { const float gt = gate[tt][0];
#pragma unroll
            for (int dt = 0; dt < 4; ++dt) oc[tt][dt] = acc[tt][dt] * gt; }
        asm volatile("s_waitcnt lgkmcnt(0)" ::: "memory"); __builtin_amdgcn_s_barrier(); asm volatile("" ::: "memory");
        {
            {
                const unsigned wsel = ((const unsigned*)(ldsb + NSA_SELQ))[lane * 8 + wv];
                const unsigned long long ltm = (lane == 0) ? 0ull : (~0ull >> (64 - lane));
#pragma unroll
                for (int jj = 0; jj < 16; ++jj) {
                    const bool bq = (wsel >> jj) & 1u;
                    const unsigned long long mk = __ballot(bq);
                    if (bq) (ldsb + NSA_QLST)[(16 * wv + jj) * 64 + __popcll(mk & ltm)] = (unsigned char)lane;
                    if (lane == 0) (ldsb + NSA_NCNT)[16 * wv + jj] = (unsigned char)__popcll(mk);
                }
            }
            if (tid < 256) {
                float* st = (float*)(ldsb + NSA_ST + tid * NSA_STB);
#pragma unroll
                for (int e = 0; e < 16; ++e) *(f32x4*)(st + 4 * e) = z4;
                *(f32x4*)(st + 64) = (f32x4){-1e30f, 0.f, 0.f, 0.f};
            }
            asm volatile("s_waitcnt vmcnt(0) lgkmcnt(0)" ::: "memory"); __builtin_amdgcn_s_barrier(); asm volatile("" ::: "memory");
        }
        nsa_slc_gather(ldsb, (const bf16_t*)(ws + O_SK) + (size_t)bg * S * 64, (const bf16_t*)(ws + O_SVT) + (size_t)bg * 64 * S, qblk, tid, i, h, t0b, g);
#pragma unroll
        for (int tt = 0; tt < 2; ++tt) {
            const float* st = (const float*)(ldsb + NSA_ST + ((8 * wv + q) * 4 + 2 * tt + r2) * NSA_STB);
            const float lt = st[65];
            const float sc = lt > 0.f ? gate[tt][1] / lt : 0.f;
#pragma unroll
            for (int dt = 0; dt < 4; ++dt) oc[tt][dt] += *(const f32x4*)(st + 16 * dt + 4 * h) * sc;
        }
        asm volatile("s_waitcnt lgkmcnt(0)" ::: "memory"); __builtin_amdgcn_s_barrier(); asm volatile("" ::: "memory");
#pragma unroll
        for (int tt = 0; tt < 2; ++tt)
#pragma unroll
            for (int dt = 0; dt < 4; ++dt) { otl[64 * (tt * 16 + dt * 4 + 0)] = oc[tt][dt][0]; otl[64 * (tt * 16 + dt * 4 + 1)] = oc[tt][dt][1]; otl[64 * (tt * 16 + dt * 4 + 2)] = oc[tt][dt][2]; otl[64 * (tt * 16 + dt * 4 + 3)] = oc[tt][dt][3]; acc[tt][dt] = z4; }
        lacc[0] = lacc[1] = z4;
        m[0] = m[1] = -1e30f; l[0] = l[1] = 0.f;
        nsa_branch<3>(ldsb, (const bf16_t*)(ws + O_WK) + (size_t)bg * S * 64, (const bf16_t*)(ws + O_WVT) + (size_t)bg * 64 * S, S, qblk >= 8 ? qblk - 8 : 0, qblk, tid, i, h, t0, sq, qf, slope2, m, l, acc, invl, 0u, 0u, 0u, 0u, impw, ncq, lacc);
#pragma unroll
        for (int tt = 0; tt < 2; ++tt) {
            const float lt = __shfl(lacc[tt][0], i);
            const float sc = lt > 0.f ? gate[tt][2] / lt : 0.f;
            bf16_t* op = YB + (size_t)tq * 768 + g * 256 + (2 * tt + r2) * 64 + 4 * h;
#pragma unroll
            for (int dt = 0; dt < 4; ++dt) { f32x4 v = acc[tt][dt] * sc; v[0] += otl[64 * (tt * 16 + dt * 4 + 0)]; v[1] += otl[64 * (tt * 16 + dt * 4 + 1)]; v[2] += otl[64 * (tt * 16 + dt * 4 + 2)]; v[3] += otl[64 * (tt * 16 + dt * 4 + 3)]; uint2 w; w.x = pg8::cvt_pk_bf16(v[0], v[1]); w.y = pg8::cvt_pk_bf16(v[2], v[3]); *(uint2*)(op + 16 * dt) = w; }
        }
    }
}

__device__ __forceinline__ void ph_proj_naive(const Params& p, float* lds) {
    const int tid = opq_tid(p.wbase), bid = opq_bid(), gsz = opq_grid(), tx = tid & 15, ty = tid >> 4;
    constexpr int NTN = 45;
    for (int tile = bid; tile < (T / 128) * NTN; tile += gsz) {
        const int rt = tile / NTN, ct = tile % NTN, row0 = rt * 128, col0 = ct * 128;
        float acc[4][8]; zero_acc(acc);
        const int ncv = (INC - col0) < 128 ? (INC - col0) : 128;
        sgemm_tile<float, float>(acc, p.x + (size_t)(row0 + (tid >> 2)) * D, nullptr, p.w_in + col0, INC, ncv, D, lds, tid);
#pragma unroll
        for (int i = 0; i < 4; ++i)
#pragma unroll
            for (int j = 0; j < 8; ++j) { const int c = col0 + tx * 8 + j; if (c < INC) store_u(p, row0 + ty * 4 + i, c, acc[i][j]); }
    }
}

__device__ __forceinline__ void ph_dilated_naive(const Params& p, float* lds) {
    const int tid = opq_tid(p.wbase), bid = opq_bid(), gsz = opq_grid(); const int lane = tid & 63, wv = tid >> 6;
    float* q = lds + wv * 64;
    const bf16_t* QA = (const bf16_t*)(p.ws + O_QA); const bf16_t* KA = (const bf16_t*)(p.ws + O_KA); const bf16_t* VAT = (const bf16_t*)(p.ws + O_VAT);
    bf16_t* YA = (bf16_t*)(p.ws + O_YA);
    for (int task = bid * NWAVES + wv; task < T * 4; task += gsz * NWAVES) {
        const int t = task >> 2, h = task & 3, b = t / S, s = t % S;
        float Mx = -INFINITY, Wsum = 0.f, Oacc = 0.f;
#pragma unroll 1
        for (int g = 0; g < 3; ++g) {
            const int d = dil_of(g), L = S / d, r = s % d, l = s / d;
            const size_t base = (size_t)((b * 3 + g) * 4 + h);
            const bf16_t* qp = QA + (base * S + (size_t)r * L + l) * 64;
            asm volatile("s_waitcnt lgkmcnt(0)" ::: "memory");
            q[lane] = bf2f(qp[lane]);
            asm volatile("s_waitcnt lgkmcnt(0)" ::: "memory");
            const float slope = exp2f(-8.0f * (float)(g * 4 + h + 1) / 12.0f);
            const int nkeys = (l + 1) < 129 ? (l + 1) : 129;
            const bf16_t* kb = KA + (base * S + (size_t)r * L) * 64;
            const bf16_t* vb = VAT + (base * 64) * S + (size_t)r * L;
            auto kf = [&](int i, const bf16_t*& kr, const bf16_t*& vc, float& bias) -> bool {
                const int kl = l - i;
                kr = kb + (size_t)kl * 64; vc = vb + kl; bias = -slope * (float)(i * d);
                return kl >= 0;
            };
            float og, ls;
            attend_naive(q, nkeys, S, kf, lane, og, ls);
            const float mm = fmaxf(Mx, ls);
            const float a = expf(Mx - mm), bb = expf(ls - mm);
            Oacc = Oacc * a + og * bb; Wsum = Wsum * a + bb; Mx = mm;
        }
        const float o = Oacc / Wsum;
        YA[(size_t)t * 256 + h * 64 + lane] = f2bf(o);
    }
}

__device__ __forceinline__ float gelu_tanh(float v) {
    const float c = 0.7978845608028654f;
    return 0.5f * v * (1.f + tanhf(c * (v + 0.044715f * v * v * v)));
}
__device__ __forceinline__ void ph_cmp1_naive(const Params& p, float* lds) {
    const int tid = opq_tid(p.wbase), bid = opq_bid(), gsz = opq_grid(), tx = tid & 15, ty = tid >> 4;
    float* HID = (float*)(p.ws + O_HID);
    for (int tile = bid; tile < 2 * 8 * 4 * 2; tile += gsz) {
        const int ct = tile & 1, rt = (tile >> 1) & 3, bg = (tile >> 3) & 7, kv = tile >> 6;
        const bf16_t* raw = (const bf16_t*)(p.ws + (kv ? O_CV : O_CK));
        const float* w1 = kv ? p.cmp_w1_v : p.cmp_w1_k; const float* pos = kv ? p.cmp_pos_v : p.cmp_pos_k;
        const int c = rt * 128 + (tid >> 2);
        const bf16_t* arow = (c < 511) ? raw + ((size_t)bg * S + 16 * c) * 64 : nullptr;
        float acc[4][8]; zero_acc(acc);
        sgemm_tile<bf16_t, float>(acc, arow, pos, w1 + ct * 128, 256, 128, 2048, lds, tid);
#pragma unroll
        for (int i = 0; i < 4; ++i)
#pragma unroll
            for (int j = 0; j < 8; ++j) {
                const int cr = rt * 128 + ty * 4 + i, n = ct * 128 + tx * 8 + j;
                HID[((size_t)(kv * 8 + bg) * 512 + cr) * 256 + n] = (cr < 511) ? gelu_tanh(acc[i][j]) : 0.f;
            }
    }
}
__device__ __forceinline__ void ph_cmp2_naive(const Params& p, float* lds) {
    const int tid = opq_tid(p.wbase), bid = opq_bid(), gsz = opq_grid(), tx = tid & 15, ty = tid >> 4;
    const float* HID = (const float*)(p.ws + O_HID);
    bf16_t* KC = (bf16_t*)(p.ws + O_KC); bf16_t* VCT = (bf16_t*)(p.ws + O_VCT);
    for (int tile = bid; tile < 2 * 8 * 4; tile += gsz) {
        const int rt = tile & 3, bg = (tile >> 2) & 7, kv = tile >> 5;
        const float* w2 = kv ? p.cmp_w2_v : p.cmp_w2_k;
        const int c = rt * 128 + (tid >> 2);
        const float* arow = HID + ((size_t)(kv * 8 + bg) * 512 + c) * 256;
        float acc[4][8]; zero_acc(acc);
        sgemm_tile<float, float>(acc, arow, nullptr, w2, 64, 64, 256, lds, tid);
#pragma unroll
        for (int i = 0; i < 4; ++i)
#pragma unroll
            for (int j = 0; j < 8; ++j) {
                const int cr = rt * 128 + ty * 4 + i, n = tx * 8 + j;
                if (n < 64) {
                    const float v = (cr < 511) ? acc[i][j] : 0.f;
                    if (kv == 0) KC[((size_t)bg * 512 + cr) * 64 + n] = f2bf(v);
                    else VCT[((size_t)bg * 64 + n) * 512 + cr] = f2bf(v);
                }
            }
    }
}

__device__ __forceinline__ void ph_nsa_naive(const Params& p, int* wl_all, float* oc_all) {
    const int tid = opq_tid(p.wbase), bid = opq_bid(), gsz = opq_grid(); const int lane = tid & 63, wv = tid >> 6;
    int* wl = wl_all + wv * 16;
    float* ocw = oc_all + wv * 512;
    float* impw = ocw + 256; float* imprw = ocw + 384;
    float* q = oc_all + 4096 + wv * 64;
    const bf16_t* BQ = (const bf16_t*)(p.ws + O_BQ);
    const bf16_t* KC = (const bf16_t*)(p.ws + O_KC); const bf16_t* VCT = (const bf16_t*)(p.ws + O_VCT);
    const bf16_t* SK = (const bf16_t*)(p.ws + O_SK); const bf16_t* SVT = (const bf16_t*)(p.ws + O_SVT);
    const bf16_t* WK = (const bf16_t*)(p.ws + O_WK); const bf16_t* WVT = (const bf16_t*)(p.ws + O_WVT);
    const float* BG = (const float*)(p.ws + O_BG);
    bf16_t* YB = (bf16_t*)(p.ws + O_YB);
    for (int task = bid * NWAVES + wv; task < NB * 2 * S; task += gsz * NWAVES) {
        const int bg = task / S, s = task % S, b = bg >> 1, g = bg & 1, t = b * S + s;
        const int ncmp = (s >= 31) ? ((s - 31) / 16 + 1) : 0;
        impw[lane] = 0.f; impw[lane + 64] = 0.f;
#pragma unroll 1
        for (int r = 0; r < 4; ++r) {
            const bf16_t* qp = BQ + (size_t)t * 512 + g * 256 + r * 64;
            asm volatile("s_waitcnt lgkmcnt(0)" ::: "memory");
            q[lane] = bf2f(qp[lane]);
            asm volatile("s_waitcnt lgkmcnt(0)" ::: "memory");
            const bf16_t* kb = KC + (size_t)bg * 512 * 64;
            const bf16_t* vb = VCT + (size_t)bg * 64 * 512;
            float m = -INFINITY;
            for (int c0 = 0; c0 < ncmp; c0 += 64) {
                const int c = c0 + lane;
                if (c < ncmp) {
                    const float sc = dot64(q, kb + (size_t)c * 64);
                    m = fmaxf(m, sc * 0.125f);
                }
            }
            m = wave_max(m);
            if (!(m > -INFINITY)) m = 0.f;
            float l = 0.f, ocv = 0.f;
            imprw[lane] = 0.f; imprw[lane + 64] = 0.f;
#pragma unroll 1
            for (int half = 0; half < 2; ++half) {
                float op[32];
#pragma unroll
                for (int d = 0; d < 32; ++d) op[d] = 0.f;
                l = 0.f;
                float carry = 0.f;
#pragma unroll 1
                for (int ch = 0; ch * 64 < ncmp; ++ch) {
                    const int c = ch * 64 + lane;
                    float pe = 0.f;
                    if (c < ncmp) {
                        const float sc = dot64(q, kb + (size_t)c * 64);
                        pe = expf(sc * 0.125f - m);
                        l += pe;
                        const bf16_t* vh = vb + (size_t)(half * 32) * 512 + c;
#pragma unroll
                        for (int d = 0; d < 32; ++d) op[d] += pe * bf2f(vh[(size_t)d * 512]);
                    }
                    if (half == 0) {
                        float quad = pe + __shfl_xor(pe, 1);
                        quad += __shfl_xor(quad, 2);
                        float prev = __shfl_up(pe, 1);
                        if (lane == 0) prev = carry;
                        if ((lane & 3) == 0) imprw[16 * ch + (lane >> 2)] = quad + prev;
                        carry = __shfl(pe, 63);
                    }
                }
                const float rr = tr_reduce32(op, lane);
                if ((lane >> 5) == half) ocv = rr;
            }
            l = wave_sum(l);
            const float inv = 1.f / fmaxf(l, TINY);
            ocw[r * 64 + lane] = ocv * inv;
            asm volatile("s_waitcnt lgkmcnt(0)" ::: "memory");
            impw[lane] += imprw[lane] * inv; impw[lane + 64] += imprw[lane + 64] * inv;
            asm volatile("s_waitcnt lgkmcnt(0)" ::: "memory");
        }
        float sc0 = impw[lane], sc1 = impw[lane + 64];
        const int cur = s >> 6;
        const int j0 = lane, j1 = lane + 64;
        const bool v0 = j0 <= cur, v1 = j1 <= cur;
        const bool f0 = (j0 == 0) || (j0 == cur) || (j0 == cur - 1), f1 = (j1 == cur) || (j1 == cur - 1);
        sc0 = v0 ? (sc0 + (f0 ? 1e4f : 0.f)) : -INFINITY;
        sc1 = v1 ? (sc1 + (f1 ? 1e4f : 0.f)) : -INFINITY;
        int rk0 = 0, rk1 = 0;
        for (int i = 0; i < 64; ++i) {
            const float a = __shfl(sc0, i), bb = __shfl(sc1, i);
            rk0 += (a > sc0 || (a == sc0 && i < j0)) ? 1 : 0;
            rk0 += (bb > sc0) ? 1 : 0;
            rk1 += (a > sc1 || (a == sc1)) ? 1 : 0;
            rk1 += (bb > sc1 || (bb == sc1 && (i + 64) < j1)) ? 1 : 0;
        }
        const bool sel0 = v0 && rk0 < 16, sel1 = v1 && rk1 < 16;
        const unsigned long long mk0 = __ballot(sel0), mk1 = __ballot(sel1);
        const unsigned long long below = (lane == 0) ? 0ull : (~0ull >> (64 - lane));
        const int n0 = __popcll(mk0);
        if (sel0) wl[__popcll(mk0 & below)] = j0;
        if (sel1) wl[n0 + __popcll(mk1 & below)] = j1;
        const int nsel = n0 + __popcll(mk1);
        asm volatile("s_waitcnt lgkmcnt(0)" ::: "memory");
#pragma unroll 1
        for (int r = 0; r < 4; ++r) {
            const bf16_t* qp = BQ + (size_t)t * 512 + g * 256 + r * 64;
            asm volatile("s_waitcnt lgkmcnt(0)" ::: "memory");
            q[lane] = bf2f(qp[lane]);
            asm volatile("s_waitcnt lgkmcnt(0)" ::: "memory");
            const float slope = exp2f(-(float)(g * 4 + r + 1));
            float os, ow, dummy;
            {
                const bf16_t* kb = SK + (size_t)bg * S * 64; const bf16_t* vb = SVT + (size_t)bg * 64 * S;
                auto kf = [&](int i, const bf16_t*& kr, const bf16_t*& vc, float& bias) -> bool {
                    const int j = wl[i >> 6];
                    const int pos = j * 64 + (i & 63);
                    kr = kb + (size_t)pos * 64; vc = vb + pos; bias = -slope * (float)(s - pos);
                    return pos <= s;
                };
                attend_naive(q, nsel * 64, S, kf, lane, os, dummy);
            }
            {
                const bf16_t* kb = WK + (size_t)bg * S * 64; const bf16_t* vb = WVT + (size_t)bg * 64 * S;
                auto kf = [&](int i, const bf16_t*& kr, const bf16_t*& vc, float& bias) -> bool {
                    const int pos = s - i;
                    kr = kb + (size_t)pos * 64; vc = vb + pos; bias = -slope * (float)i;
                    return pos >= 0;
                };
                attend_naive(q, 512, S, kf, lane, ow, dummy);
            }
            const float* gp = BG + (size_t)t * 24 + g * 12 + r * 3;
            const float o = gp[0] * ocw[r * 64 + lane] + gp[1] * os + gp[2] * ow;
            YB[(size_t)t * 512 + g * 256 + r * 64 + lane] = f2bf(o);
        }
        asm volatile("s_waitcnt lgkmcnt(0)" ::: "memory");
    }
}

__device__ __forceinline__ void ph_merge_naive(const Params& p, float* lds) {
    const int tid = opq_tid(p.wbase), bid = opq_bid(), gsz = opq_grid(), tx = tid & 15, ty = tid >> 4;
    const bf16_t* YA = (const bf16_t*)(p.ws + O_YA); const bf16_t* YB = (const bf16_t*)(p.ws + O_YB); const bf16_t* MG = (const bf16_t*)(p.ws + O_MG);
    bf16_t* MERGED = (bf16_t*)(p.ws + O_MERGED);
    for (int tile = bid; tile < (T / 128) * 8; tile += gsz) {
        const int rt = tile >> 3, ct = tile & 7, row0 = rt * 128, col0 = ct * 128;
        float acc1[4][8], acc2[4][8]; zero_acc(acc1); zero_acc(acc2);
        sgemm_tile<bf16_t, float>(acc1, YA + (size_t)(row0 + (tid >> 2)) * 256, nullptr, p.w_br_a + col0, D, 128, 256, lds, tid);
        sgemm_tile<bf16_t, float>(acc2, YB + (size_t)(row0 + (tid >> 2)) * 512, nullptr, p.w_br_b + col0, D, 128, 512, lds, tid);
#pragma unroll
        for (int i = 0; i < 4; ++i) {
            const int r = row0 + ty * 4 + i, c = col0 + tx * 8;
            const uint4 ga = *(const uint4*)(MG + (size_t)r * 2048 + c), gb = *(const uint4*)(MG + (size_t)r * 2048 + 1024 + c);
            const unsigned gau[4] = {ga.x, ga.y, ga.z, ga.w}, gbu[4] = {gb.x, gb.y, gb.z, gb.w};
            unsigned o[4];
#pragma unroll
            for (int j = 0; j < 4; ++j) {
                const float lo = __uint_as_float(gau[j] << 16) * acc1[i][2 * j] + __uint_as_float(gbu[j] << 16) * acc2[i][2 * j];
                const float hi = __uint_as_float(gau[j] & 0xffff0000u) * acc1[i][2 * j + 1] + __uint_as_float(gbu[j] & 0xffff0000u) * acc2[i][2 * j + 1];
                o[j] = (unsigned)f2bf(lo) | ((unsigned)f2bf(hi) << 16);
            }
            *(uint4*)(MERGED + (size_t)r * D + c) = make_uint4(o[0], o[1], o[2], o[3]);
            asm volatile("" ::: "memory");
        }
    }
}
__device__ __forceinline__ void ph_wout_naive(const Params& p, float* lds) {
    const int tid = opq_tid(p.wbase), bid = opq_bid(), gsz = opq_grid(), tx = tid & 15, ty = tid >> 4;
    const bf16_t* MERGED = (const bf16_t*)(p.ws + O_MERGED);
    for (int tile = bid; tile < (T / 128) * 8; tile += gsz) {
        const int rt = tile >> 3, ct = tile & 7, row0 = rt * 128, col0 = ct * 128;
        float acc[4][8]; zero_acc(acc);
        sgemm_tile<bf16_t, float>(acc, MERGED + (size_t)(row0 + (tid >> 2)) * D, nullptr, p.w_out + col0, D, 128, D, lds, tid);
#pragma unroll
        for (int i = 0; i < 4; ++i) {
            const size_t off = (size_t)(row0 + ty * 4 + i) * D + col0 + tx * 8;
            const float4 x0 = *(const float4*)(p.x + off), x1 = *(const float4*)(p.x + off + 4);
            *(float4*)(p.out + off) = make_float4(ALPHA * x0.x + acc[i][0], ALPHA * x0.y + acc[i][1], ALPHA * x0.z + acc[i][2], ALPHA * x0.w + acc[i][3]);
            *(float4*)(p.out + off + 4) = make_float4(ALPHA * x1.x + acc[i][4], ALPHA * x1.y + acc[i][5], ALPHA * x1.z + acc[i][6], ALPHA * x1.w + acc[i][7]);
            asm volatile("" ::: "memory");
        }
    }
}
__device__ __forceinline__ void ph_ln1_route(const Params& p, float* lds) {
    const int tid = opq_tid(p.wbase), bid = opq_bid(), gsz = opq_grid(); const int lane = tid & 63, wv = tid >> 6;
    float* hrow = lds + wv * 1024;
    bf16_t* H1B = (bf16_t*)(p.ws + O_H1B);
    int* LIST = (int*)(p.ws + O_LIST); float* WTS = (float*)(p.ws + O_WTS); int* CNT = (int*)(p.ws + O_CNT); int* ES = (int*)(p.ws + O_ES);
    for (int t = bid * NWAVES + wv; t < T; t += gsz * NWAVES) {
        float* row = p.out + (size_t)t * D;
        float v[16];
#pragma unroll
        for (int j = 0; j < 4; ++j) { const float4 f = *(const float4*)(row + j * 256 + lane * 4); v[j * 4] = f.x; v[j * 4 + 1] = f.y; v[j * 4 + 2] = f.z; v[j * 4 + 3] = f.w; }
        float sm = 0.f;
#pragma unroll
        for (int j = 0; j < 16; ++j) sm += v[j];
        const float mu = wave_sum(sm) * (1.f / D);
        float sq = 0.f;
#pragma unroll
        for (int j = 0; j < 16; ++j) { v[j] -= mu; sq += v[j] * v[j]; }
        const float rstd = rsqrtf(wave_sum(sq) * (1.f / D) + LN_EPS);
#pragma unroll
        for (int j = 0; j < 4; ++j) {
#pragma unroll
            for (int e = 0; e < 4; ++e) { const int k = j * 256 + lane * 4 + e; v[j * 4 + e] = v[j * 4 + e] * rstd * p.ln1_g[k] + p.ln1_b[k]; }
            *(float4*)(row + j * 256 + lane * 4) = make_float4(v[j * 4], v[j * 4 + 1], v[j * 4 + 2], v[j * 4 + 3]);
            ushort4 hb; hb.x = f2bf(v[j * 4]); hb.y = f2bf(v[j * 4 + 1]); hb.z = f2bf(v[j * 4 + 2]); hb.w = f2bf(v[j * 4 + 3]);
            *(ushort4*)(H1B + (size_t)t * D + j * 256 + lane * 4) = hb;
        }
        asm volatile("s_waitcnt lgkmcnt(0)" ::: "memory");
#pragma unroll
        for (int j = 0; j < 16; ++j) hrow[j * 64 + lane] = v[j];
        asm volatile("s_waitcnt lgkmcnt(0)" ::: "memory");
        float lc[4], lf[4][8];
#pragma unroll
        for (int o = 0; o < 4; ++o) { lc[o] = 0.f;
#pragma unroll
            for (int e = 0; e < 8; ++e) lf[o][e] = 0.f; }
#pragma unroll 1
        for (int j = 0; j < 16; ++j) {
            const int k = (j >> 2) * 256 + lane * 4 + (j & 3);
            const float hv = hrow[j * 64 + lane];
            const float4 wc = *(const float4*)(p.w_coarse + (size_t)k * 4);
            lc[0] += hv * wc.x; lc[1] += hv * wc.y; lc[2] += hv * wc.z; lc[3] += hv * wc.w;
#pragma unroll
            for (int gg = 0; gg < 4; ++gg) {
                const float4 wa = *(const float4*)(p.w_fine + ((size_t)gg * D + k) * 8), wb = *(const float4*)(p.w_fine + ((size_t)gg * D + k) * 8 + 4);
                lf[gg][0] += hv * wa.x; lf[gg][1] += hv * wa.y; lf[gg][2] += hv * wa.z; lf[gg][3] += hv * wa.w;
                lf[gg][4] += hv * wb.x; lf[gg][5] += hv * wb.y; lf[gg][6] += hv * wb.z; lf[gg][7] += hv * wb.w;
            }
        }
#pragma unroll
        for (int o = 0; o < 4; ++o) { lc[o] = wave_sum(lc[o]) + p.b_coarse[o];
#pragma unroll
            for (int e = 0; e < 8; ++e) lf[o][e] = wave_sum(lf[o][e]) + p.b_fine[o * 8 + e]; }
        int grp = 0; float mx = lc[0];
#pragma unroll
        for (int o = 1; o < 4; ++o) if (lc[o] > mx) { mx = lc[o]; grp = o; }
        float den = 0.f;
#pragma unroll
        for (int o = 0; o < 4; ++o) den += expf(lc[o] - mx);
        const float pg = 1.f / den;
        float f[8];
#pragma unroll
        for (int e = 0; e < 8; ++e) f[e] = grp == 0 ? lf[0][e] : (grp == 1 ? lf[1][e] : (grp == 2 ? lf[2][e] : lf[3][e]));
        int i1 = 0; float m1 = f[0];
#pragma unroll
        for (int e = 1; e < 8; ++e) if (f[e] > m1) { m1 = f[e]; i1 = e; }
        int i2 = -1; float m2 = -INFINITY;
#pragma unroll
        for (int e = 0; e < 8; ++e) if (e != i1 && f[e] > m2) { m2 = f[e]; i2 = e; }
        const float e2 = expf(m2 - m1);
        const float wa1 = pg / (1.f + e2), wa2 = pg * e2 / (1.f + e2);
        if (lane == 0) {
            const int ex1 = grp * 8 + i1, ex2 = grp * 8 + i2;
            const int s1 = atomicAdd(&CNT[ex1], 1); LIST[(size_t)ex1 * T + s1] = 2 * t; WTS[2 * t] = wa1; ES[2 * t] = ex1 * 65536 + s1;
            const int s2 = atomicAdd(&CNT[ex2], 1); LIST[(size_t)ex2 * T + s2] = 2 * t + 1; WTS[2 * t + 1] = wa2; ES[2 * t + 1] = ex2 * 65536 + s2;
        }
    }
}
__device__ __forceinline__ void ph_moe_up_naive(const Params& p, float* lds) {
    const int tid = opq_tid(p.wbase), bid = opq_bid(), gsz = opq_grid(), tx = tid & 15, ty = tid >> 4;
    const int* LIST = (const int*)(p.ws + O_LIST); const int* CNT = (const int*)(p.ws + O_CNT);
    bf16_t* ACT = (bf16_t*)(p.ws + O_ACT);
    int total = 0;
    for (int e = 0; e < NEXP; ++e) total += ((CNT[e] + 127) >> 7) * 4;
    for (int tile = bid; tile < total; tile += gsz) {
        int e = 0, rem = tile;
        for (; e < NEXP; ++e) { const int n = ((CNT[e] + 127) >> 7) * 4; if (rem < n) break; rem -= n; }
        const int blk = rem >> 2, ct = rem & 3, cnt = CNT[e];
        const int lr = blk * 128 + (tid >> 2);
        const float* arow = (lr < cnt) ? p.out + (size_t)(LIST[(size_t)e * T + lr] >> 1) * D : nullptr;
        float ag[4][8], au[4][8]; zero_acc(ag); zero_acc(au);
        const float* W = p.w_gate_up + (size_t)e * D * 1024;
        sgemm_tile<float, float>(ag, arow, nullptr, W + ct * 128, 1024, 128, D, lds, tid);
        sgemm_tile<float, float>(au, arow, nullptr, W + 512 + ct * 128, 1024, 128, D, lds, tid);
#pragma unroll
        for (int i = 0; i < 4; ++i) {
            const int rr = blk * 128 + ty * 4 + i;
            if (rr < cnt) {
                const int aid = LIST[(size_t)e * T + rr];
                unsigned o[4];
#pragma unroll
                for (int j = 0; j < 4; ++j) {
                    const float g0 = ag[i][2 * j], g1 = ag[i][2 * j + 1];
                    o[j] = (unsigned)f2bf(g0 / (1.f + expf(-g0)) * au[i][2 * j]) | ((unsigned)f2bf(g1 / (1.f + expf(-g1)) * au[i][2 * j + 1]) << 16);
                }
                *(uint4*)(ACT + (size_t)aid * DEXP + ct * 128 + tx * 8) = make_uint4(o[0], o[1], o[2], o[3]);
            }
            asm volatile("" ::: "memory");
        }
    }
}
__device__ __forceinline__ void ph_moe_down_naive(const Params& p, float* lds) {
    const int tid = opq_tid(p.wbase), bid = opq_bid(), gsz = opq_grid(), tx = tid & 15, ty = tid >> 4;
    const int* LIST = (const int*)(p.ws + O_LIST); const int* CNT = (const int*)(p.ws + O_CNT);
    const bf16_t* ACT = (const bf16_t*)(p.ws + O_ACT); bf16_t* YE = (bf16_t*)(p.ws + O_YE);
    int total = 0;
    for (int e = 0; e < NEXP; ++e) total += ((CNT[e] + 127) >> 7) * 8;
    for (int tile = bid; tile < total; tile += gsz) {
        int e = 0, rem = tile;
        for (; e < NEXP; ++e) { const int n = ((CNT[e] + 127) >> 7) * 8; if (rem < n) break; rem -= n; }
        const int blk = rem >> 3, ct = rem & 7, cnt = CNT[e];
        const int lr = blk * 128 + (tid >> 2);
        const bf16_t* arow = (lr < cnt) ? ACT + (size_t)LIST[(size_t)e * T + lr] * DEXP : nullptr;
        float acc[4][8]; zero_acc(acc);
        sgemm_tile<bf16_t, float>(acc, arow, nullptr, p.w_down + (size_t)e * DEXP * D + ct * 128, D, 128, DEXP, lds, tid);
#pragma unroll
        for (int i = 0; i < 4; ++i) {
            const int rr = blk * 128 + ty * 4 + i;
            if (rr < cnt) {
                const int aid = LIST[(size_t)e * T + rr];
                unsigned o[4];
#pragma unroll
                for (int j = 0; j < 4; ++j) o[j] = (unsigned)f2bf(acc[i][2 * j]) | ((unsigned)f2bf(acc[i][2 * j + 1]) << 16);
                *(uint4*)(YE + (size_t)aid * D + ct * 128 + tx * 8) = make_uint4(o[0], o[1], o[2], o[3]);
            }
            asm volatile("" ::: "memory");
        }
    }
}
__device__ __forceinline__ void ph_final(const Params& p) {
    const int tid = opq_tid(p.wbase), bid = opq_bid(), gsz = opq_grid(); const int lane = tid & 63, wv = tid >> 6;
    const bf16_t* YE = (const bf16_t*)(p.ws + O_YE); const float* WTS = (const float*)(p.ws + O_WTS);
    for (int t = bid * NWAVES + wv; t < T; t += gsz * NWAVES) {
        float* row = p.out + (size_t)t * D;
        const float w0 = WTS[2 * t], w1 = WTS[2 * t + 1];
        float v[16];
#pragma unroll
        for (int j = 0; j < 4; ++j) {
            const float4 f = *(const float4*)(row + j * 256 + lane * 4);
            const ushort4 a = *(const ushort4*)(YE + (size_t)(2 * t) * D + j * 256 + lane * 4), bq = *(const ushort4*)(YE + (size_t)(2 * t + 1) * D + j * 256 + lane * 4);
            v[j * 4] = ALPHA * f.x + w0 * bf2f(a.x) + w1 * bf2f(bq.x); v[j * 4 + 1] = ALPHA * f.y + w0 * bf2f(a.y) + w1 * bf2f(bq.y);
            v[j * 4 + 2] = ALPHA * f.z + w0 * bf2f(a.z) + w1 * bf2f(bq.z); v[j * 4 + 3] = ALPHA * f.w + w0 * bf2f(a.w) + w1 * bf2f(bq.w);
        }
        float sm = 0.f;
#pragma unroll
        for (int j = 0; j < 16; ++j) sm += v[j];
        const float mu = wave_sum(sm) * (1.f / D);
        float sq = 0.f;
#pragma unroll
        for (int j = 0; j < 16; ++j) { v[j] -= mu; sq += v[j] * v[j]; }
        const float rstd = rsqrtf(wave_sum(sq) * (1.f / D) + LN_EPS);
#pragma unroll
        for (int j = 0; j < 4; ++j) {
#pragma unroll
            for (int e = 0; e < 4; ++e) { const int k = j * 256 + lane * 4 + e; v[j * 4 + e] = v[j * 4 + e] * rstd * p.ln2_g[k] + p.ln2_b[k]; }
            *(float4*)(row + j * 256 + lane * 4) = make_float4(v[j * 4], v[j * 4 + 1], v[j * 4 + 2], v[j * 4 + 3]);
        }
    }
}


#define LDS_WAIT() asm volatile("s_waitcnt lgkmcnt(0)" ::: "memory")
#define VM_WAIT() asm volatile("s_waitcnt vmcnt(0)" ::: "memory")
#define XB_TMO      128
#define XB_XCNT(j)  (256  + 64 * (j))
#define XB_XSUB(j)  (1280 + 64 * (j))
#define XB_XGEN(j)  (2304 + 64 * (j))
#define XB_TOP      3328
#define XB_TOPGEN   3392
#define XCD_BAR_WORDS 3456
#define XB_SPIN_CAP (1u << 18)

__device__ __forceinline__ unsigned xb_ld(unsigned* p)              { return __hip_atomic_load(p, __ATOMIC_RELAXED, __HIP_MEMORY_SCOPE_AGENT); }
__device__ __forceinline__ unsigned xb_add(unsigned* p, unsigned v) { return __hip_atomic_fetch_add(p, v, __ATOMIC_RELAXED, __HIP_MEMORY_SCOPE_AGENT); }
__device__ __forceinline__ unsigned xb_xcc_id() { return (unsigned)__builtin_amdgcn_s_getreg((3 << 11) | 20) & 0xFu; }
#define XB_SPIN(cond, bar) do { unsigned _sp = 0; while (cond) { __builtin_amdgcn_s_sleep(1); \
    if ((++_sp & 255u) == 0u) { if (xb_ld(&(bar)[XB_TMO])) break; if (_sp > XB_SPIN_CAP) { atomicAdd(&(bar)[XB_TMO], 1u); break; } } } } while (0)

struct XcdBarrier {
    unsigned* bar; unsigned x;
    volatile LAS unsigned* st;
};

__device__ __forceinline__ XcdBarrier xcd_barrier_post(unsigned* bar, volatile LAS unsigned* st) {
    XcdBarrier b; b.bar = bar; b.x = xb_xcc_id(); b.st = st;
    if (threadIdx.x == 0) (void)xb_add(&bar[XB_XCNT(b.x)], 1u);
    return b;
}
__device__ __forceinline__ void xcd_barrier_complete(unsigned* bar, unsigned x, unsigned& nloc, unsigned& nx) {
    const unsigned G = gridDim.x * gridDim.y * gridDim.z;
    unsigned sum, cnt, mine, sp = 0u;
    for (;;) {
        sum = 0u; cnt = 0u; mine = 0u;
#pragma unroll
        for (unsigned j = 0; j < 16; ++j) { const unsigned c = xb_ld(&bar[XB_XCNT(j)]); sum += c; cnt += (c > 0u) ? 1u : 0u; mine = (j == x) ? c : mine; }
        if (sum == G) break;
        __builtin_amdgcn_s_sleep(1);
        if ((++sp & 255u) == 0u) { if (xb_ld(&bar[XB_TMO])) break; if (sp > XB_SPIN_CAP) { atomicAdd(&bar[XB_TMO], 1u); break; } }
    }
    nloc = mine > 0u ? mine : 1u; nx = cnt > 0u ? cnt : 1u;
}

__device__ __forceinline__ void xcd_barrier(const XcdBarrier& b) {
    asm volatile("s_waitcnt vmcnt(0)" ::: "memory");
    __syncthreads();
    if (threadIdx.x == 0) {
        unsigned* bar = b.bar;
        __builtin_amdgcn_s_waitcnt(0);
        unsigned nloc = b.st[0], nx = b.st[1];
        if (nloc == 0u) { xcd_barrier_complete(bar, b.x, nloc, nx); b.st[0] = nloc; b.st[1] = nx; }
        const unsigned old = xb_add(&bar[XB_XSUB(b.x)], 1u);
        const unsigned gen = old / nloc;
        if (old + 1u == (gen + 1u) * nloc) {
            __builtin_amdgcn_fence(__ATOMIC_RELEASE, "agent");
            asm volatile("s_waitcnt vmcnt(0)" ::: "memory");
            const unsigned og = xb_add(&bar[XB_TOP], 1u);
            const unsigned tg = og / nx;
            if (og + 1u == (tg + 1u) * nx) xb_add(&bar[XB_TOPGEN], 1u);
            else XB_SPIN(xb_ld(&bar[XB_TOPGEN]) == tg, bar);
            __builtin_amdgcn_fence(__ATOMIC_ACQUIRE, "agent");
            xb_add(&bar[XB_XGEN(b.x)], 1u);
            asm volatile("s_waitcnt vmcnt(0)" ::: "memory");
        } else {
            XB_SPIN(xb_ld(&bar[XB_XGEN(b.x)]) == gen, bar);
            __builtin_amdgcn_fence(__ATOMIC_ACQUIRE, "agent");
            asm volatile("s_waitcnt vmcnt(0)" ::: "memory");
        }
    }
    __syncthreads();
}


constexpr int NPHASE = 11;
template <int LO, int HI> __global__ void __launch_bounds__(NTHREADS, 2) mega(Params p_arg) {
    __shared__ __attribute__((aligned(16))) unsigned char ldsb[LDS_BYTES];
    const int wbase_ = __builtin_amdgcn_readfirstlane((int)(threadIdx.x & ~63u));
    (void)p_arg;
    float* lds = (float*)ldsb;
    int* wl = (int*)(lds + 8192);
    cg::grid_group grid = cg::this_grid();
    volatile LAS unsigned* bst = (volatile LAS unsigned*)((LAS unsigned char*)ldsb + (LDS_BYTES - 64));
    if (threadIdx.x < 16) bst[threadIdx.x] = 0u;
    __syncthreads();
    XcdBarrier xbar; { const Params p0 = get_params(wbase_); xbar = xcd_barrier_post((unsigned*)(p0.ws + O_CNT + 16384), bst); }
    grid.sync();
#define RUN_PHASE(N, BODY) do { if constexpr (LO <= (N) && (N) < HI) { if ((N) > LO) xcd_barrier(xbar); const Params p = get_params(wbase_); BODY; } } while (0)
    RUN_PHASE(0, ph_prologue(p, ldsb));
    RUN_PHASE(1, ph_proj(p, ldsb));
    RUN_PHASE(2, { ph_cmp1(p, ldsb); __syncthreads(); ph_cmp2(p, ldsb); __syncthreads(); ph_dilated2(p, ldsb); });
    RUN_PHASE(4, { ph_combine(p); ph_nsa2(p, ldsb); });
    RUN_PHASE(5, ph_merge(p, ldsb));
    RUN_PHASE(6, ph_wout(p, ldsb));
    RUN_PHASE(7, { if (opq_bid() & 1) { moe_weight_convert_range(p, ldsb, CONV_EARLY, NEXP * (16 * 16 + 8 * 16), opq_bid() * NWAVES + (opq_tid(p.wbase) >> 6), opq_grid() * NWAVES); __syncthreads(); ph_ln1_route2(p, ldsb); }
                   else { ph_ln1_route2(p, ldsb); __syncthreads(); moe_weight_convert_range(p, ldsb, CONV_EARLY, NEXP * (16 * 16 + 8 * 16), opq_bid() * NWAVES + (opq_tid(p.wbase) >> 6), opq_grid() * NWAVES); } });
    RUN_PHASE(8, ph_moe_up(p, ldsb));
    RUN_PHASE(9, ph_moe_down(p, ldsb));
    RUN_PHASE(10, ph_final2(p));
}

template <int N> static void launch_phase(const Params& p, int grid_blocks, hipStream_t stream) {
    hipLaunchKernelGGL((mega<N, N + 1>), dim3(grid_blocks), dim3(NTHREADS), 0, stream, p);
}

extern "C" void kernel_launch(void* const* d_in, const int* in_sizes, int n_in, void* d_out, int out_size, void* d_ws, size_t ws_size, hipStream_t stream) {
    if (n_in != 21 || ws_size < WS_NEED || out_size != T * D) { fprintf(stderr, "kernel_launch: unexpected shapes n_in=%d ws=%zu out=%d\n", n_in, ws_size, out_size); return; }
    static int grid_blocks = 0;
    if (!grid_blocks) {
        int dev = 0, cus = 0;
        (void)hipGetDevice(&dev);
        (void)hipDeviceGetAttribute(&cus, hipDeviceAttributeMultiprocessorCount, dev);
        grid_blocks = cus;
#if ONE_LAUNCH
        int per_cu = 0;
        (void)hipOccupancyMaxActiveBlocksPerMultiprocessor(&per_cu, mega<0, NPHASE>, NTHREADS, 0);
        fprintf(stderr, "kernel_launch: cus=%d per_cu=%d grid=%d\n", cus, per_cu, grid_blocks);
#endif
    }
    Params p{};
    const float** pp = (const float**)&p;
    for (int i = 0; i < 21; ++i) pp[i] = (const float*)d_in[i];
    p.out = (float*)d_out; p.ws = (unsigned char*)d_ws;
    (void)hipMemsetAsync((unsigned char*)d_ws + O_CNT, 0, 32768, stream);
#if ONE_LAUNCH
    void* args[] = {&p};
    hipError_t e = hipLaunchCooperativeKernel((void*)mega<0, NPHASE>, dim3(grid_blocks), dim3(NTHREADS), args, 0, stream);
    if (e != hipSuccess) fprintf(stderr, "cooperative launch failed: %s (grid %d)\n", hipGetErrorString(e), grid_blocks);
#else
    launch_phase<0>(p, grid_blocks, stream); launch_phase<1>(p, grid_blocks, stream); launch_phase<2>(p, grid_blocks, stream); launch_phase<3>(p, grid_blocks, stream);
    launch_phase<4>(p, grid_blocks, stream); launch_phase<5>(p, grid_blocks, stream); launch_phase<6>(p, grid_blocks, stream); launch_phase<7>(p, grid_blocks, stream);
    launch_phase<8>(p, grid_blocks, stream); launch_phase<9>(p, grid_blocks, stream); launch_phase<10>(p, grid_blocks, stream);
#endif
}
```
